# Optimizing an MI355X kernel written in HIP

```python
import jax, jax.numpy as jnp
from jax import lax
import numpy as np

D_MODEL = 1024
BATCH = 4
SEQ = 8192
DEPTH = 1

HEAD_DIM = 64
ROT_DIM = HEAD_DIM // 4
ROPE_THETA = 500000.0
BLOCK = 128
N_MEM = 256
D_MIX = D_MODEL
C_HEADS = 4
C_W = C_HEADS * HEAD_DIM
A_Q_HEADS = (D_MIX - C_W) // (2 * HEAD_DIM)
A_KV_HEADS = 2
A_GROUP = A_Q_HEADS // A_KV_HEADS
A_W = A_Q_HEADS * HEAD_DIM
A_KV_W = A_KV_HEADS * HEAD_DIM
A_WINDOW = 128
B_HEADS = A_Q_HEADS
B_W = B_HEADS * HEAD_DIM
B_CONFIGS = ((128, 1), (512, 4), (2048, 16))
RMS_EPS = 1e-6
IN_WIDTHS = (A_W, A_KV_W, A_KV_W, A_W,
             B_W, B_W, B_W, B_W,
             C_W, C_W)
D_IN = sum(IN_WIDTHS)
IN_SPLITS = tuple(int(s) for s in np.cumsum(IN_WIDTHS)[:-1])

kernel_name = "hybrid_swa_sink_dilated_memxattn_layer"


def rms_norm(x, g):
    xf = x.astype(jnp.float32)
    y = xf * lax.rsqrt(jnp.mean(xf * xf, axis=-1, keepdims=True) + RMS_EPS)
    return (y * g.astype(jnp.float32)).astype(x.dtype)


def rope_tables(seq):
    inv_freq = ROPE_THETA ** (-jnp.arange(0, ROT_DIM, 2, dtype=jnp.float32) / ROT_DIM)
    ang = jnp.arange(seq, dtype=jnp.float32)[:, None] * inv_freq[None, :]
    return jnp.cos(ang)[:, None, :], jnp.sin(ang)[:, None, :]


def apply_partial_rope(t, cos, sin):
    tf = t.astype(jnp.float32)
    half = ROT_DIM // 2
    r1, r2, rest = tf[..., :half], tf[..., half:ROT_DIM], tf[..., ROT_DIM:]
    out = jnp.concatenate([r1 * cos - r2 * sin, r2 * cos + r1 * sin, rest], axis=-1)
    return out.astype(t.dtype)


def banded_attention(q, k, v, max_dist, sink):
    N, L, KVH, G, Dh = q.shape
    nb = -(-L // BLOCK)
    Lp = nb * BLOCK
    pad = Lp - L
    n_prev = -(-max_dist // BLOCK)
    W = (n_prev + 1) * BLOCK
    qp = jnp.pad(q, ((0, 0), (0, pad), (0, 0), (0, 0), (0, 0)))
    kp = jnp.pad(k, ((0, 0), (n_prev * BLOCK, pad), (0, 0), (0, 0)))
    vp = jnp.pad(v, ((0, 0), (n_prev * BLOCK, pad), (0, 0), (0, 0)))

    def windows(t):
        return jnp.concatenate(
            [t[:, j * BLOCK:(j + nb) * BLOCK].reshape(N, nb, BLOCK, KVH, Dh)
             for j in range(n_prev + 1)], axis=2)

    kw, vw = windows(kp), windows(vp)
    qb = qp.reshape(N, nb, BLOCK, KVH, G, Dh)
    s = jnp.einsum('nbqhgd,nbkhd->nbhgqk', qb, kw,
                   preferred_element_type=jnp.float32)
    qi = jnp.arange(BLOCK)[:, None]
    kj = jnp.arange(W)[None, :]
    dist = qi + n_prev * BLOCK - kj
    kpos = jnp.arange(nb)[:, None, None] * BLOCK + kj[None] - n_prev * BLOCK
    mask = (dist >= 0)[None] & (dist <= max_dist)[None] & (kpos >= 0)
    s = jnp.where(mask[:, None, None], s, -jnp.inf)
    m = jnp.max(s, axis=-1)
    if sink is not None:
        sink_b = sink.astype(jnp.float32)[None, None, :, :, None]
        m = jnp.maximum(m, sink_b)
    p = jnp.exp(s - m[..., None])
    denom = jnp.sum(p, axis=-1)
    if sink is not None:
        denom = denom + jnp.exp(sink_b - m)
    o = jnp.einsum('nbhgqk,nbkhd->nbqhgd', p, vw.astype(jnp.float32))
    o = o / jnp.moveaxis(denom, -1, 2)[..., None]
    lse = jnp.moveaxis(m + jnp.log(denom), -1, 2)
    o = o.reshape(N, Lp, KVH, G, Dh)[:, :L]
    lse = lse.reshape(N, Lp, KVH, G)[:, :L]
    return o.astype(q.dtype), lse


def to_strided(t, d):
    B, S = t.shape[:2]
    rest = t.shape[2:]
    t = t.reshape((B, S // d, d) + rest)
    t = jnp.moveaxis(t, 2, 1)
    return t.reshape((B * d, S // d) + rest)


def from_strided(t, B, d):
    L = t.shape[1]
    rest = t.shape[2:]
    t = t.reshape((B, d, L) + rest)
    t = jnp.moveaxis(t, 1, 2)
    return t.reshape((B, d * L) + rest)


def setup_inputs(seed: int = 0) -> dict:
    key = jax.random.key(seed)
    ks = jax.random.split(key, 10)
    f32 = jnp.float32
    x = jax.random.normal(ks[0], (BATCH, SEQ, D_MODEL), f32)
    mem = jax.random.normal(ks[1], (BATCH, N_MEM, D_MODEL), f32)
    pre_norm = 1.0 + 0.02 * jax.random.normal(ks[2], (DEPTH, D_MODEL), f32)
    w_in = jax.random.normal(ks[3], (DEPTH, D_MODEL, D_IN), f32) * D_MODEL ** -0.5
    sink_a = 0.5 * jax.random.normal(ks[4], (DEPTH, A_Q_HEADS), f32)
    mem_norm = 1.0 + 0.02 * jax.random.normal(ks[5], (DEPTH, D_MODEL), f32)
    w_mem_kv = jax.random.normal(ks[6], (DEPTH, D_MODEL, 2 * C_W), f32) * D_MODEL ** -0.5
    w_out = jax.random.normal(ks[7], (DEPTH, D_MIX, D_MODEL), f32) * D_MIX ** -0.5
    post_norm = 1.0 + 0.02 * jax.random.normal(ks[8], (DEPTH, D_MODEL), f32)
    return {"x": x, "mem": mem, "pre_norm": pre_norm, "w_in": w_in,
            "sink_a": sink_a, "mem_norm": mem_norm, "w_mem_kv": w_mem_kv,
            "w_out": w_out, "post_norm": post_norm}


def reference(x, mem, pre_norm, w_in, sink_a, mem_norm, w_mem_kv, w_out, post_norm):
    B, S, _ = x.shape
    scale = HEAD_DIM ** -0.5
    cos, sin = rope_tables(S)
    h = x
    for l in range(DEPTH):
        u = rms_norm(h, pre_norm[l])
        proj = jnp.einsum('bsd,de->bse', u, w_in[l])
        qa, ka, va, ga, qb, kb, vb, gb, qc, gc = jnp.split(proj, IN_SPLITS, axis=-1)

        qa = apply_partial_rope(qa.reshape(B, S, A_Q_HEADS, HEAD_DIM), cos, sin)
        qa = qa.reshape(B, S, A_KV_HEADS, A_GROUP, HEAD_DIM)
        ka = apply_partial_rope(ka.reshape(B, S, A_KV_HEADS, HEAD_DIM), cos, sin)
        va = va.reshape(B, S, A_KV_HEADS, HEAD_DIM)
        sink = sink_a[l].reshape(A_KV_HEADS, A_GROUP)
        oa, _ = banded_attention(qa * scale, ka, va, A_WINDOW - 1, sink)
        oa = oa.reshape(B, S, A_W)

        qb = apply_partial_rope(qb.reshape(B, S, B_HEADS, HEAD_DIM), cos, sin)
        kb = apply_partial_rope(kb.reshape(B, S, B_HEADS, HEAD_DIM), cos, sin)
        vb = vb.reshape(B, S, B_HEADS, HEAD_DIM)
        outs, lses = [], []
        for (win, dil) in B_CONFIGS:
            qs = to_strided(qb * scale, dil)[:, :, :, None, :]
            o, lse = banded_attention(qs, to_strided(kb, dil), to_strided(vb, dil),
                                      win // dil, None)
            outs.append(from_strided(o[:, :, :, 0], B, dil).astype(jnp.float32))
            lses.append(from_strided(lse[..., 0], B, dil))
        wts = jax.nn.softmax(jnp.stack(lses, axis=0), axis=0)
        ob = jnp.sum(wts[..., None] * jnp.stack(outs, axis=0), axis=0)
        ob = ob.astype(x.dtype).reshape(B, S, B_W)

        mkv = jnp.einsum('bmd,de->bme', rms_norm(mem, mem_norm[l]), w_mem_kv[l])
        mk, mv = jnp.split(mkv, 2, axis=-1)
        mk = mk.reshape(B, N_MEM, C_HEADS, HEAD_DIM)
        mv = mv.reshape(B, N_MEM, C_HEADS, HEAD_DIM)
        qc = qc.reshape(B, S, C_HEADS, HEAD_DIM)
        sc = jnp.einsum('bshd,bmhd->bhsm', qc * scale, mk,
                        preferred_element_type=jnp.float32)
        pc = jax.nn.softmax(sc, axis=-1)
        oc = jnp.einsum('bhsm,bmhd->bshd', pc, mv.astype(jnp.float32))
        oc = oc.astype(x.dtype).reshape(B, S, C_W)

        y = jnp.concatenate([oa * jax.nn.silu(ga), ob * jax.nn.silu(gb),
                             oc * jax.nn.silu(gc)], axis=-1)
        y = jnp.einsum('bse,ed->bsd', y, w_out[l])
        h = h + rms_norm(y, post_norm[l])
    return h
```

```cpp
#include <hip/hip_runtime.h>
#include <hip/hip_cooperative_groups.h>
#include <cstdio>
namespace cg = cooperative_groups;
namespace pg8 {
#define PG8_LAS __attribute__((address_space(3)))
typedef unsigned short bf16_t;
typedef short bf16x8 __attribute__((ext_vector_type(8)));
typedef float f32x4 __attribute__((ext_vector_type(4)));
typedef unsigned u32x4 __attribute__((ext_vector_type(4)));
constexpr int BM = 256, BK = 64, HALF = 128, HTB = HALF * BK * 2  , STAGE_BYTES = 8 * HTB, NXCD = 8, WGM = 8;

__host__ __device__ __forceinline__ int lds_byte(int r, int c) { const int st = (r >> 4) * 2 + (c >> 5), rr = r & 15, cc = c & 31, ob = rr * 64 + cc * 2; return st * 1024 + (ob ^ (((ob >> 9) & 1) << 5)); }
__host__ __device__ __forceinline__ void stage_rc(int b, int& R, int& C) { const int st = b / 1024, sb = b % 1024, swz = sb ^ (((sb >> 9) & 1) << 5); R = (st >> 1) * 16 + swz / 64; C = (st & 1) * 32 + (swz % 64) / 2; }
__host__ __device__ __forceinline__ int perm32(int rho) { const int n = rho >> 4, i = rho & 15; return 8 * (i >> 2) + 4 * n + (i & 3); }

struct Unit { int pm, pn; };
struct Gemm { const bf16_t* A; const bf16_t* Bt; int M, N, K; };
struct StaticOrder {
    int nM, nN, nwg, G, c;
    __host__ __device__ void init(int M, int N, int G_, int c_) { nM = M / BM; nN = N / BM; nwg = nM * nN; G = G_; c = c_; }
    __host__ __device__ bool next(int i, Unit& u) const {
        const long L = (long)i * G + c; if (L >= nwg) return false;
        int wgid = (int)L; { const int q = nwg / NXCD, r = nwg % NXCD, xcd = wgid % NXCD, off = wgid / NXCD; wgid = (xcd < r ? xcd * (q + 1) : r * (q + 1) + (xcd - r) * q) + off; }
        const int nig = WGM * nN, gid = wgid / nig, fm = gid * WGM, gsz = (nM - fm) < WGM ? (nM - fm) : WGM;
        u.pm = fm + ((wgid % nig) % gsz); u.pn = (wgid % nig) / gsz; return true;
    }
    __device__ __forceinline__ void a_ready(const Unit&) const {}
    __device__ __forceinline__ void done(const Unit&) const {}
};
__device__ __forceinline__ unsigned cvt_pk_bf16(float lo, float hi) { unsigned r; asm volatile("v_cvt_pk_bf16_f32 %0, %1, %2" : "=v"(r) : "v"(lo), "v"(hi)); return r; }
struct EpiF32 {
    static constexpr bool PERM = false, AFTER_DRAIN = false;
    float* C; int ldc; const float* bias;
    __device__ __forceinline__ void operator()(const f32x4 (&acc)[2][2][4][2], const Unit& u, int wr, int wc, int fr, int fq) const {
        const int row0 = u.pm * BM + wr * 64 + fr, col0 = u.pn * BM + wc * 32 + 4 * fq;
        f32x4 bv[2][2];
#pragma unroll
        for (int bj = 0; bj < 2; ++bj)
#pragma unroll
            for (int n = 0; n < 2; ++n) bv[bj][n] = bias ? *(const f32x4*)(bias + col0 + bj * HALF + n * 16) : (f32x4){0.f, 0.f, 0.f, 0.f};
#pragma unroll
        for (int ai = 0; ai < 2; ++ai)
#pragma unroll
            for (int m = 0; m < 4; ++m) { float* rowp = C + (size_t)(row0 + ai * HALF + m * 16) * ldc + col0;
#pragma unroll
                for (int bj = 0; bj < 2; ++bj)
#pragma unroll
                    for (int n = 0; n < 2; ++n) *(f32x4*)(rowp + bj * HALF + n * 16) = acc[ai][bj][m][n] + bv[bj][n]; }
    }
};
template <class Epi, class Sched, bool STAMP = false>
__device__ __forceinline__ void gemm_phase(PG8_LAS unsigned char* lds, const Gemm g, const Sched& S, const Epi& E, unsigned long long* stamps) {
    const int tid = threadIdx.x, wid = __builtin_amdgcn_readfirstlane(tid >> 6), lane = tid & 63, wr = wid >> 2, wc = wid & 3, fr = lane & 15, fq = lane >> 4;
    const int K = g.K, nt = K / BK;
#define PG8_STAMP() do {} while (0)
    unsigned voffA[2], voffB[2];
#pragma unroll
    for (int i = 0; i < 2; ++i) { int R, C; stage_rc(tid * 16 + i * 8192, R, C); const int Rb = Epi::PERM ? ((R & ~31) + perm32(R & 31)) : R;
        voffA[i] = (unsigned)(R * K + C) * 2u; voffB[i] = (unsigned)(Rb * K + C) * 2u; }
    const size_t kstep = (size_t)(BK * 2);
    const size_t hstep = (size_t)HALF * K * 2;
    const size_t tstep = 2 * hstep;
    const unsigned ldsw = (unsigned)wid * 1024u;
    const int aoff = lds_byte(wr * 64 + fr, fq * 8), boff = lds_byte(wc * 32 + fr, fq * 8);
#define PG8_SA(b, h) (((b) * 2 + (h)) * HTB)
#define PG8_SB(b, h) ((4 + (b) * 2 + (h)) * HTB)
#define PG8_STAGE(bufoff, gbase, voff) do { _Pragma("unroll") for (int _i = 0; _i < 2; ++_i) \
        __builtin_amdgcn_global_load_lds((const unsigned*)((const char*)(gbase) + (voff)[_i]), (PG8_LAS unsigned*)(lds + (bufoff) + ldsw + _i * 8192), 16, 0, 0); } while (0)
#define PG8_LDA(dst, b, h) do { _Pragma("unroll") for (int m = 0; m < 4; ++m) _Pragma("unroll") for (int k = 0; k < 2; ++k) dst[m][k] = *(const PG8_LAS bf16x8*)(lds + PG8_SA(b, h) + aoff + m * 2048 + k * 1024); } while (0)
#define PG8_LDB(dst, b, h) do { _Pragma("unroll") for (int n = 0; n < 2; ++n) _Pragma("unroll") for (int k = 0; k < 2; ++k) dst[n][k] = *(const PG8_LAS bf16x8*)(lds + PG8_SB(b, h) + boff + n * 2048 + k * 1024); } while (0)
#define PG8_MMA(ai, bj, At, Bt) do { __builtin_amdgcn_s_setprio(1); _Pragma("unroll") for (int m = 0; m < 4; ++m) _Pragma("unroll") for (int n = 0; n < 2; ++n) _Pragma("unroll") for (int k = 0; k < 2; ++k) \
        acc[ai][bj][m][n] = __builtin_amdgcn_mfma_f32_16x16x32_bf16(Bt[n][k], At[m][k], acc[ai][bj][m][n], 0, 0, 0); __builtin_amdgcn_s_setprio(0); } while (0)
#define PG8_WAIT_V(n) asm volatile("s_waitcnt vmcnt(" #n ")" ::: "memory")
#define PG8_WAIT_L(n) asm volatile("s_waitcnt lgkmcnt(" #n ")" ::: "memory")
#define PG8_BAR __builtin_amdgcn_s_barrier()
#define PG8_SCHED __builtin_amdgcn_sched_barrier(0)
    Unit cur, nxt; int ui = 0;
    if (!S.next(0, cur)) return;
    f32x4 acc[2][2][4][2];
#pragma unroll
    for (int a = 0; a < 2; ++a)
#pragma unroll
        for (int b = 0; b < 2; ++b)
#pragma unroll
            for (int m = 0; m < 4; ++m)
#pragma unroll
                for (int n = 0; n < 2; ++n) acc[a][b][m][n] = (f32x4){0.f, 0.f, 0.f, 0.f};
    bf16x8 At[4][2], B0[2][2], B1[2][2];
    const char* cA = (const char*)g.A + (size_t)cur.pm * tstep; const char* cB = (const char*)g.Bt + (size_t)cur.pn * tstep;
    S.a_ready(cur);
    PG8_STAGE(PG8_SB(0, 0), cB, voffB); PG8_STAGE(PG8_SA(0, 0), cA, voffA); PG8_STAGE(PG8_SB(0, 1), cB + hstep, voffB); PG8_STAGE(PG8_SA(0, 1), cA + hstep, voffA);
    if (wr == 1) PG8_BAR;
    PG8_WAIT_V(4); PG8_BAR;
    PG8_STAGE(PG8_SB(1, 0), cB + kstep, voffB); PG8_STAGE(PG8_SA(1, 0), cA + kstep, voffA); PG8_STAGE(PG8_SB(1, 1), cB + hstep + kstep, voffB);
    PG8_WAIT_V(6); PG8_BAR;
    PG8_STAMP();
    for (;;) {
        const bool has_next = S.next(ui + 1, nxt);
        const char* nA = has_next ? (const char*)g.A + (size_t)nxt.pm * tstep : cA; const char* nB = has_next ? (const char*)g.Bt + (size_t)nxt.pn * tstep : cB;
        for (int t = 0; t < nt; t += 2) {
            const bool last = (t == nt - 2);
            const char* a1 = cA + (size_t)(t + 1) * kstep;
            const char* a2 = last ? nA : cA + (size_t)(t + 2) * kstep; const char* b2 = last ? nB : cB + (size_t)(t + 2) * kstep;
            const char* a3 = a2 + kstep; const char* b3 = b2 + kstep;
            if (last && has_next) S.a_ready(nxt);
            PG8_LDB(B0, 0, 0); PG8_SCHED; PG8_LDA(At, 0, 0); PG8_STAGE(PG8_SA(1, 1), a1 + hstep, voffA);
            PG8_WAIT_L(8); PG8_BAR; PG8_WAIT_L(0); PG8_MMA(0, 0, At, B0); PG8_BAR; PG8_SCHED;
            PG8_LDB(B1, 0, 1); PG8_STAGE(PG8_SB(0, 0), b2, voffB);
            PG8_BAR; PG8_WAIT_L(0); PG8_MMA(0, 1, At, B1); PG8_BAR;
            PG8_LDA(At, 0, 1); PG8_STAGE(PG8_SA(0, 0), a2, voffA);
            PG8_BAR; PG8_WAIT_L(0); PG8_MMA(1, 0, At, B0); PG8_BAR; PG8_SCHED;
            PG8_STAGE(PG8_SB(0, 1), b2 + hstep, voffB);
            PG8_WAIT_V(6); PG8_BAR; PG8_MMA(1, 1, At, B1); PG8_BAR;
            PG8_LDB(B0, 1, 0); PG8_SCHED; PG8_LDA(At, 1, 0); PG8_STAGE(PG8_SA(0, 1), a2 + hstep, voffA);
            PG8_WAIT_L(8); PG8_BAR; PG8_WAIT_L(0); PG8_MMA(0, 0, At, B0); PG8_BAR; PG8_SCHED;
            PG8_LDB(B1, 1, 1); PG8_STAGE(PG8_SB(1, 0), b3, voffB);
            PG8_BAR; PG8_WAIT_L(0); PG8_MMA(0, 1, At, B1); PG8_BAR;
            PG8_LDA(At, 1, 1); PG8_STAGE(PG8_SA(1, 0), a3, voffA);
            PG8_BAR; PG8_WAIT_L(0); PG8_MMA(1, 0, At, B0); PG8_BAR; PG8_SCHED;
            PG8_STAGE(PG8_SB(1, 1), b3 + hstep, voffB);
            PG8_WAIT_V(6); PG8_BAR; PG8_MMA(1, 1, At, B1); PG8_BAR;
        }
        PG8_STAMP();
        if constexpr (!Epi::AFTER_DRAIN) { E(acc, cur, wr, wc, fr, fq); S.done(cur); }
        PG8_STAMP();
        if (!has_next) break;
#pragma unroll
        for (int a = 0; a < 2; ++a)
#pragma unroll
            for (int b = 0; b < 2; ++b)
#pragma unroll
                for (int m = 0; m < 4; ++m)
#pragma unroll
                    for (int n = 0; n < 2; ++n) acc[a][b][m][n] = (f32x4){0.f, 0.f, 0.f, 0.f};
        cur = nxt; cA = nA; cB = nB; ++ui;
    }
    PG8_WAIT_V(0);
    if (wr == 0) PG8_BAR;
    PG8_BAR;
    if constexpr (Epi::AFTER_DRAIN) { E.fused(acc, cur, wr, wc, fr, fq, lds, wid, lane); S.done(cur); }
    PG8_STAMP();
#undef PG8_STAMP
#undef PG8_SA
#undef PG8_SB
#undef PG8_STAGE
#undef PG8_LDA
#undef PG8_LDB
#undef PG8_MMA
#undef PG8_WAIT_V
#undef PG8_WAIT_L
#undef PG8_BAR
#undef PG8_SCHED
}
}
using pg8::bf16_t; using pg8::bf16x8; using pg8::f32x4; using pg8::u32x4; using pg8::Unit;
#define LAS __attribute__((address_space(3)))
typedef short s16x4 __attribute__((ext_vector_type(4)));
typedef float f32x16 __attribute__((ext_vector_type(16)));
typedef float f32x2 __attribute__((ext_vector_type(2)));
typedef __bf16 bf16x2_t __attribute__((ext_vector_type(2)));
typedef unsigned u32x2 __attribute__((ext_vector_type(2)));

constexpr int NTOK = 32768, SEQ = 8192, DM = 1024, DIN = 3072, MROWS = 32768 + 1024;
constexpr size_t OFF_U = 0, OFF_WINT = 69206016, OFF_WOUTT = 76546048, OFF_ROPE = 78643200, OFF_MKV = 79167488, OFF_CTR = 80216064,
                 OFF_Y = 80216320, OFF_PROJ = 147325184, OFF_Z = OFF_PROJ;
constexpr int LDS_BYTES = 131072;
constexpr int ST_ROWB = 136, ST_ML = 69632, ST_V = 73728, ST_VW = 6144, ST_ITEM = 122880, VROWB = 192;

struct Params { const float *x, *mem, *pre_g, *w_in, *sink, *mem_g, *w_memkv, *w_out, *post_g; float* out; unsigned char* ws; };

__device__ __forceinline__ unsigned pack2(float lo, float hi) { f32x2 v; v.x = lo; v.y = hi; return __builtin_bit_cast(unsigned, __builtin_convertvector(v, bf16x2_t)); }
__device__ __forceinline__ float bflo(unsigned w) { return __uint_as_float(w << 16); }
__device__ __forceinline__ float bfhi(unsigned w) { return __uint_as_float(w & 0xffff0000u); }
__device__ __forceinline__ float wave_sum(float v) {
#pragma unroll
    for (int o = 32; o >= 1; o >>= 1) v += __shfl_xor(v, o);
    return v;
}

__device__ __forceinline__ void transpose_cvt(const float* __restrict__ W, int N, bf16_t* __restrict__ WT, int gt, int nt) {
    const int total = 128 * N;
    for (int it = gt; it < total; it += nt) {
        const int k8 = it / N, n = it - k8 * N;
        const float* s = W + (size_t)(8 * k8) * N + n;
        float v[8];
#pragma unroll
        for (int j = 0; j < 8; ++j) v[j] = s[(size_t)j * N];
        u32x4 w; w.x = pack2(v[0], v[1]); w.y = pack2(v[2], v[3]); w.z = pack2(v[4], v[5]); w.w = pack2(v[6], v[7]);
        *(u32x4*)(WT + (size_t)n * 1024 + 8 * k8) = w;
    }
}
__device__ __forceinline__ void phase_prep(const Params& p) {
    const int tid = threadIdx.x, lane = tid & 63, wid = tid >> 6;
    const int gw = blockIdx.x * 8 + wid, nw = gridDim.x * 8, gt = blockIdx.x * 512 + tid, nt = gridDim.x * 512;
    bf16_t* U = (bf16_t*)(p.ws + OFF_U);
    if (blockIdx.x == 0 && tid == 0) *(unsigned*)(p.ws + OFF_CTR) = 0u;
    for (int row = gw; row < MROWS; row += nw) {
        const float* src = row < NTOK ? p.x + (size_t)row * DM : p.mem + (size_t)(row - NTOK) * DM;
        const float* g = row < NTOK ? p.pre_g : p.mem_g;
        f32x4 v[4];
#pragma unroll
        for (int i = 0; i < 4; ++i) v[i] = *(const f32x4*)(src + i * 256 + lane * 4);
        float ss = 0.f;
#pragma unroll
        for (int i = 0; i < 4; ++i) ss += v[i][0] * v[i][0] + v[i][1] * v[i][1] + v[i][2] * v[i][2] + v[i][3] * v[i][3];
        ss = wave_sum(ss);
        const float r = rsqrtf(ss * (1.0f / 1024.0f) + 1e-6f);
#pragma unroll
        for (int i = 0; i < 4; ++i) {
            const f32x4 gg = *(const f32x4*)(g + i * 256 + lane * 4);
            u32x2 w; w.x = pack2(v[i][0] * r * gg[0], v[i][1] * r * gg[1]); w.y = pack2(v[i][2] * r * gg[2], v[i][3] * r * gg[3]);
            *(u32x2*)(U + (size_t)row * DM + i * 256 + lane * 4) = w;
        }
    }
    bf16_t* WinT = (bf16_t*)(p.ws + OFF_WINT);
    transpose_cvt(p.w_in, 3072, WinT, gt, nt);
    transpose_cvt(p.w_memkv, 512, WinT + (size_t)3072 * 1024, gt, nt);
    transpose_cvt(p.w_out, 1024, (bf16_t*)(p.ws + OFF_WOUTT), gt, nt);
    float* rope = (float*)(p.ws + OFF_ROPE);
    for (int it = gt; it < SEQ * 8; it += nt) {
        const int pos = it >> 3, i = it & 7;
        const float inv = (float)pow(500000.0, -(double)i * 0.125);
        const float ang = (float)pos * inv;
        rope[pos * 16 + i] = cosf(ang); rope[pos * 16 + 8 + i] = sinf(ang);
    }
}

struct InOrder {
    pg8::StaticOrder so;
    __device__ bool next(int i, Unit& u) const {
        if (so.next(i, u)) return true;
        const long L = (long)i * so.G + so.c - so.nwg;
        if (L < 8) { u.pm = 128 + (int)(L >> 1); u.pn = 12 + (int)(L & 1); return true; }
        return false;
    }
    __device__ __forceinline__ void a_ready(const Unit&) const {}
    __device__ __forceinline__ void done(const Unit&) const {}
};
struct EpiIn {
    static constexpr bool PERM = true, AFTER_DRAIN = false;
    bf16_t* proj; bf16_t* mkv; const float* rope;
    __device__ __forceinline__ void operator()(const f32x4 (&acc)[2][2][4][2], const Unit& u, int wr, int wc, int fr, int fq) const {
        if (u.pm >= 128) {
            const int row0 = (u.pm - 128) * 256 + wr * 64 + fr, col0 = (u.pn - 12) * 256 + wc * 32 + 8 * fq;
#pragma unroll
            for (int ai = 0; ai < 2; ++ai)
#pragma unroll
                for (int m = 0; m < 4; ++m) { bf16_t* rowp = mkv + (size_t)(row0 + ai * 128 + m * 16) * 512 + col0;
#pragma unroll
                    for (int bj = 0; bj < 2; ++bj) { const f32x4 v0 = acc[ai][bj][m][0], v1 = acc[ai][bj][m][1];
                        u32x4 w; w.x = pack2(v0[0], v0[1]); w.y = pack2(v0[2], v0[3]); w.z = pack2(v1[0], v1[1]); w.w = pack2(v1[2], v1[3]);
                        *(u32x4*)(rowp + bj * 128) = w; } }
            return;
        }
        const int row0 = u.pm * 256 + wr * 64 + fr;
#pragma unroll
        for (int bj = 0; bj < 2; ++bj) {
            const int cg0 = u.pn * 256 + bj * 128 + wc * 32;
            const float scale = (cg0 < 384 || (cg0 >= 1024 && cg0 < 1408) || (cg0 >= 2560 && cg0 < 2816)) ? 0.125f : 1.0f;
            const bool rope_on = (cg0 < 512 || (cg0 >= 1024 && cg0 < 1792)) && ((cg0 & 63) == 0);
#pragma unroll
            for (int ai = 0; ai < 2; ++ai)
#pragma unroll
                for (int m = 0; m < 4; ++m) {
                    const int row = row0 + ai * 128 + m * 16;
                    f32x4 v0 = acc[ai][bj][m][0], v1 = acc[ai][bj][m][1];
                    if (rope_on) {
                        f32x4 p0, p1;
#pragma unroll
                        for (int j = 0; j < 4; ++j) { p0[j] = __shfl_xor(v0[j], 16); p1[j] = __shfl_xor(v1[j], 16); }
                        if (fq < 2) {
                            const float* cs = rope + (size_t)(row & (SEQ - 1)) * 16;
                            const f32x4 c0 = *(const f32x4*)(cs), c1 = *(const f32x4*)(cs + 4), s0 = *(const f32x4*)(cs + 8), s1 = *(const f32x4*)(cs + 12);
                            const float sg = fq == 0 ? -1.0f : 1.0f;
                            v0 = v0 * c0 + sg * (p0 * s0); v1 = v1 * c1 + sg * (p1 * s1);
                        }
                    }
                    v0 *= scale; v1 *= scale;
                    u32x4 w; w.x = pack2(v0[0], v0[1]); w.y = pack2(v0[2], v0[3]); w.z = pack2(v1[0], v1[1]); w.w = pack2(v1[2], v1[3]);
                    *(u32x4*)(proj + (size_t)row * DIN + cg0 + 8 * fq) = w;
                }
        }
    }
};

__device__ __forceinline__ int crow(int r, int h) { return (r & 3) + 8 * (r >> 2) + 4 * h; }
#define MFMA32(a, b, c) __builtin_amdgcn_mfma_f32_32x32x16_bf16((a), (b), (c), 0, 0, 0)

template <int MODE, int NKT>
__device__ __forceinline__ void attn_core(const bf16_t* __restrict__ qrow, const bf16_t* __restrict__ kb, const bf16_t* __restrict__ vb, const int ld, const int res, const int dil,
                                          const int kidx0, const int nq, const int maxd, float& m, float& l, f32x16& o0, f32x16& o1, LAS unsigned char* vl, const int lane) {
    const int c = lane & 31, h = lane >> 5;
    bf16x8 qf[4];
#pragma unroll
    for (int kk = 0; kk < 4; ++kk) qf[kk] = *(const bf16x8*)(qrow + 16 * kk + 8 * h);
    const int q4 = (lane & 15) >> 2, p4 = lane & 3, g2 = (lane >> 4) & 1;
    LAS unsigned char* trb = vl + (4 * h + q4) * VROWB + 32 * g2 + 8 * p4;
    const int vr = lane >> 3, vc = lane & 7;
    LAS unsigned char* vw = vl + vr * VROWB + vc * 16;
    bf16x8 kf[4]; u32x4 vreg[4];
#define LOAD_TILE(kt) do { \
        int _j = kidx0 + 32 * (kt) + c; _j = _j < 0 ? 0 : _j; \
        const bf16_t* _kr = kb + (size_t)(res + dil * _j) * ld + 8 * h; \
        _Pragma("unroll") for (int kk = 0; kk < 4; ++kk) kf[kk] = *(const bf16x8*)(_kr + 16 * kk); \
        _Pragma("unroll") for (int i = 0; i < 4; ++i) { int _jv = kidx0 + 32 * (kt) + vr + 8 * i; _jv = _jv < 0 ? 0 : _jv; \
            vreg[i] = *(const u32x4*)(vb + (size_t)(res + dil * _jv) * ld + vc * 8); } } while (0)
    LOAD_TILE(0);
#pragma unroll 1
    for (int kt = 0; kt < NKT; ++kt) {
#pragma unroll
        for (int i = 0; i < 4; ++i) *(LAS u32x4*)(vw + i * 8 * VROWB) = vreg[i];
        bf16x8 kc[4];
#pragma unroll
        for (int kk = 0; kk < 4; ++kk) kc[kk] = kf[kk];
        { const int ktn = kt + 1 < NKT ? kt + 1 : kt; LOAD_TILE(ktn); }
        f32x16 s;
#pragma unroll
        for (int r = 0; r < 16; ++r) s[r] = 0.f;
#pragma unroll
        for (int kk = 0; kk < 4; ++kk) s = MFMA32(kc[kk], qf[kk], s);
        if (MODE != 2 && (kt == 0 || kt == NKT - 1)) {
            const int nkb = kidx0 + 32 * kt;
#pragma unroll
            for (int r = 0; r < 16; ++r) { const int nk = nkb + crow(r, h), dist = nq - nk; s[r] = (nk >= 0 && dist >= 0 && dist <= maxd) ? s[r] : -INFINITY; }
        } else if (MODE != 2) {
            const int nkb = kidx0 + 32 * kt;
            if (nkb < 0) {
#pragma unroll
                for (int r = 0; r < 16; ++r) { const int nk = nkb + crow(r, h); s[r] = nk >= 0 ? s[r] : -INFINITY; }
            }
        }
        float mx = s[0];
#pragma unroll
        for (int r = 1; r < 16; ++r) mx = fmaxf(mx, s[r]);
        mx = fmaxf(mx, __shfl_xor(mx, 32));
        const float mnew = fmaxf(m, mx), msafe = mnew == -INFINITY ? 0.f : mnew;
        const float alpha = __expf(m - msafe);
        float rs = 0.f;
#pragma unroll
        for (int r = 0; r < 16; ++r) { s[r] = __expf(s[r] - msafe); rs += s[r]; }
        rs += __shfl_xor(rs, 32);
        l = l * alpha + rs; m = mnew;
        o0 *= alpha; o1 *= alpha;
        bf16x8 pf[2];
#pragma unroll
        for (int s2 = 0; s2 < 2; ++s2) { u32x4 w; w.x = pack2(s[8 * s2], s[8 * s2 + 1]); w.y = pack2(s[8 * s2 + 2], s[8 * s2 + 3]); w.z = pack2(s[8 * s2 + 4], s[8 * s2 + 5]); w.w = pack2(s[8 * s2 + 6], s[8 * s2 + 7]);
            pf[s2] = __builtin_bit_cast(bf16x8, w); }
#pragma unroll
        for (int s2 = 0; s2 < 2; ++s2) {
            const s16x4 a0 = __builtin_amdgcn_ds_read_tr16_b64_v4i16((LAS s16x4*)(trb + (16 * s2) * VROWB));
            const s16x4 a1 = __builtin_amdgcn_ds_read_tr16_b64_v4i16((LAS s16x4*)(trb + (16 * s2 + 8) * VROWB));
            const s16x4 b0 = __builtin_amdgcn_ds_read_tr16_b64_v4i16((LAS s16x4*)(trb + (16 * s2) * VROWB + 64));
            const s16x4 b1 = __builtin_amdgcn_ds_read_tr16_b64_v4i16((LAS s16x4*)(trb + (16 * s2 + 8) * VROWB + 64));
            const bf16x8 va = __builtin_shufflevector(a0, a1, 0, 1, 2, 3, 4, 5, 6, 7), vbv = __builtin_shufflevector(b0, b1, 0, 1, 2, 3, 4, 5, 6, 7);
            o0 = MFMA32(va, pf[s2], o0);
            o1 = MFMA32(vbv, pf[s2], o1);
        }
    }
#undef LOAD_TILE
}

__device__ __forceinline__ float silu(float g) { return g / (1.0f + __expf(-g)); }
__device__ __forceinline__ void attn_finalize(const f32x16& o0, const f32x16& o1, float l, const bf16_t* __restrict__ grow, bf16_t* __restrict__ yrow, int h) {
    const float inv = 1.0f / l;
#pragma unroll
    for (int cc = 0; cc < 2; ++cc)
#pragma unroll
        for (int g = 0; g < 4; ++g) {
            const int d0 = 32 * cc + 8 * g + 4 * h;
            const u32x2 gv = *(const u32x2*)(grow + d0);
            const f32x16& o = cc ? o1 : o0;
            const float y0 = o[4 * g] * inv * silu(bflo(gv.x)), y1 = o[4 * g + 1] * inv * silu(bfhi(gv.x)), y2 = o[4 * g + 2] * inv * silu(bflo(gv.y)), y3 = o[4 * g + 3] * inv * silu(bfhi(gv.y));
            u32x2 w; w.x = pack2(y0, y1); w.y = pack2(y2, y3);
            *(u32x2*)(yrow + d0) = w;
        }
}

__device__ __forceinline__ void phase_attn(const Params& p, LAS unsigned char* lds) {
    const bf16_t* proj = (const bf16_t*)(p.ws + OFF_PROJ); const bf16_t* mkv = (const bf16_t*)(p.ws + OFF_MKV); bf16_t* Y = (bf16_t*)(p.ws + OFF_Y);
    unsigned* ctr = (unsigned*)(p.ws + OFF_CTR);
    const int tid = threadIdx.x, lane = tid & 63, wid = tid >> 6, c = lane & 31, h = lane >> 5;
    LAS unsigned char* vl = lds + ST_V + wid * ST_VW;
    LAS int* item_s = (LAS int*)(lds + ST_ITEM);
    for (;;) {
        if (tid == 0) *item_s = (int)atomicAdd(ctr, 1u);
        __syncthreads();
        const int item = *item_s;
        __syncthreads();
        if (item >= 1024) break;
        if (item < 384) {
            const int st = item / 6, head = item - st * 6, b = st >> 4, t0 = (st & 15) * 512;
            const bf16_t* pb = proj + (size_t)b * SEQ * DIN;
#pragma unroll 1
            for (int pass = 0; pass < 3; ++pass) {
                const int dil = pass == 0 ? 16 : (pass == 1 ? 4 : 1);
#pragma unroll 1
                for (int su = wid; su < 16; su += 8) {
                    int res, n0;
                    if (pass == 0) { res = su; n0 = t0 >> 4; } else if (pass == 1) { res = su & 3; n0 = (t0 >> 2) + 32 * (su >> 2); } else { res = 0; n0 = t0 + 32 * su; }
                    const int nq = n0 + c, posq = res + dil * nq, tokl = posq - t0, rowp = tokl ^ ((tokl >> 4) & 15);
                    LAS unsigned char* so = lds + rowp * ST_ROWB + 8 * h;
                    LAS float* sml = (LAS float*)(lds + ST_ML + rowp * 8);
                    float m, l; f32x16 o0, o1;
                    if (pass == 0) { m = -INFINITY; l = 0.f;
#pragma unroll
                        for (int r = 0; r < 16; ++r) { o0[r] = 0.f; o1[r] = 0.f; }
                    } else {
                        m = sml[0]; l = sml[1];
#pragma unroll
                        for (int g = 0; g < 4; ++g) {
                            const u32x2 a = *(LAS u32x2*)(so + 16 * g), bb = *(LAS u32x2*)(so + 64 + 16 * g);
                            o0[4 * g] = bflo(a.x); o0[4 * g + 1] = bfhi(a.x); o0[4 * g + 2] = bflo(a.y); o0[4 * g + 3] = bfhi(a.y);
                            o1[4 * g] = bflo(bb.x); o1[4 * g + 1] = bfhi(bb.x); o1[4 * g + 2] = bflo(bb.y); o1[4 * g + 3] = bfhi(bb.y);
                        }
                    }
                    attn_core<1, 5>(pb + (size_t)posq * DIN + 1024 + head * 64, pb + 1408 + head * 64, pb + 1792 + head * 64, DIN, res, dil, n0 - 128, nq, 128, m, l, o0, o1, vl, lane);
                    if (pass < 2) {
                        if (h == 0) { sml[0] = m; sml[1] = l; }
#pragma unroll
                        for (int g = 0; g < 4; ++g) {
                            u32x2 a, bb; a.x = pack2(o0[4 * g], o0[4 * g + 1]); a.y = pack2(o0[4 * g + 2], o0[4 * g + 3]); bb.x = pack2(o1[4 * g], o1[4 * g + 1]); bb.y = pack2(o1[4 * g + 2], o1[4 * g + 3]);
                            *(LAS u32x2*)(so + 16 * g) = a; *(LAS u32x2*)(so + 64 + 16 * g) = bb;
                        }
                    } else {
                        const size_t row = (size_t)b * SEQ + posq;
                        attn_finalize(o0, o1, l, proj + row * DIN + 2176 + head * 64, Y + row * DM + 384 + head * 64, h);
                    }
                }
                __syncthreads();
            }
        } else if (item < 640) {
            const int idx = item - 384, st = idx >> 2, head = idx & 3, b = st >> 4, t0 = (st & 15) * 512;
            const bf16_t* kb = mkv + (size_t)b * 256 * 512 + head * 64;
#pragma unroll 1
            for (int su = wid; su < 16; su += 8) {
                const size_t row = (size_t)b * SEQ + t0 + 32 * su + c;
                float m = -INFINITY, l = 0.f; f32x16 o0, o1;
#pragma unroll
                for (int r = 0; r < 16; ++r) { o0[r] = 0.f; o1[r] = 0.f; }
                attn_core<2, 8>(proj + row * DIN + 2560 + head * 64, kb, kb + 256, 512, 0, 1, 0, 0, 0, m, l, o0, o1, vl, lane);
                attn_finalize(o0, o1, l, proj + row * DIN + 2816 + head * 64, Y + row * DM + 768 + head * 64, h);
            }
        } else {
            const int idx = item - 640, st = idx / 6, qh = idx - st * 6, kvh = qh / 3, b = st >> 4, t0 = (st & 15) * 512;
            const bf16_t* pb = proj + (size_t)b * SEQ * DIN;
            const float sink = p.sink[qh];
#pragma unroll 1
            for (int su = wid; su < 16; su += 8) {
                const int n0 = t0 + 32 * su, nq = n0 + c;
                const size_t row = (size_t)b * SEQ + nq;
                float m = sink, l = 1.0f; f32x16 o0, o1;
#pragma unroll
                for (int r = 0; r < 16; ++r) { o0[r] = 0.f; o1[r] = 0.f; }
                attn_core<0, 5>(pb + (size_t)nq * DIN + qh * 64, pb + 384 + kvh * 64, pb + 512 + kvh * 64, DIN, 0, 1, n0 - 128, nq, 127, m, l, o0, o1, vl, lane);
                attn_finalize(o0, o1, l, proj + row * DIN + 640 + qh * 64, Y + row * DM + qh * 64, h);
            }
        }
    }
}

__device__ __forceinline__ void phase_post(const Params& p) {
    const int tid = threadIdx.x, lane = tid & 63, wid = tid >> 6, gw = blockIdx.x * 8 + wid, nw = gridDim.x * 8;
    const float* Z = (const float*)(p.ws + OFF_Z);
    for (int row = gw; row < NTOK; row += nw) {
        f32x4 v[4];
#pragma unroll
        for (int i = 0; i < 4; ++i) v[i] = *(const f32x4*)(Z + (size_t)row * DM + i * 256 + lane * 4);
        float ss = 0.f;
#pragma unroll
        for (int i = 0; i < 4; ++i) ss += v[i][0] * v[i][0] + v[i][1] * v[i][1] + v[i][2] * v[i][2] + v[i][3] * v[i][3];
        ss = wave_sum(ss);
        const float r = rsqrtf(ss * (1.0f / 1024.0f) + 1e-6f);
#pragma unroll
        for (int i = 0; i < 4; ++i) {
            const f32x4 gg = *(const f32x4*)(p.post_g + i * 256 + lane * 4), xx = *(const f32x4*)(p.x + (size_t)row * DM + i * 256 + lane * 4);
            *(f32x4*)(p.out + (size_t)row * DM + i * 256 + lane * 4) = xx + v[i] * r * gg;
        }
    }
}

__global__ __launch_bounds__(512, 2) void fwd_kernel(Params p) {
    extern __shared__ __attribute__((aligned(16))) unsigned char smem[];
    cg::grid_group grid = cg::this_grid();
    LAS unsigned char* lds = (LAS unsigned char*)smem;
    phase_prep(p);
    grid.sync();
    {
        pg8::Gemm g; g.A = (const bf16_t*)(p.ws + OFF_U); g.Bt = (const bf16_t*)(p.ws + OFF_WINT); g.M = NTOK; g.N = DIN; g.K = DM;
        InOrder S; S.so.init(NTOK, DIN, (int)gridDim.x, (int)blockIdx.x);
        EpiIn E; E.proj = (bf16_t*)(p.ws + OFF_PROJ); E.mkv = (bf16_t*)(p.ws + OFF_MKV); E.rope = (const float*)(p.ws + OFF_ROPE);
        pg8::gemm_phase<EpiIn, InOrder, false>(lds, g, S, E, nullptr);
    }
    grid.sync();
    phase_attn(p, lds);
    grid.sync();
    {
        pg8::Gemm g; g.A = (const bf16_t*)(p.ws + OFF_Y); g.Bt = (const bf16_t*)(p.ws + OFF_WOUTT); g.M = NTOK; g.N = DM; g.K = DM;
        pg8::StaticOrder S; S.init(NTOK, DM, (int)gridDim.x, (int)blockIdx.x);
        pg8::EpiF32 E; E.C = (float*)(p.ws + OFF_Z); E.ldc = DM; E.bias = nullptr;
        pg8::gemm_phase<pg8::EpiF32, pg8::StaticOrder, false>(lds, g, S, E, nullptr);
    }
    grid.sync();
    phase_post(p);
}

extern "C" void kernel_launch(void* const* d_in, const int* in_sizes, int n_in, void* d_out, int out_size, void* d_ws, size_t ws_size, hipStream_t stream) {
    static int grid_blocks = 0;
    if (!grid_blocks) {
        int dev = 0, cus = 0, per_cu = 0;
        hipGetDevice(&dev);
        hipDeviceGetAttribute(&cus, hipDeviceAttributeMultiprocessorCount, dev);
        hipFuncSetAttribute((const void*)fwd_kernel, hipFuncAttributeMaxDynamicSharedMemorySize, LDS_BYTES);
        hipOccupancyMaxActiveBlocksPerMultiprocessor(&per_cu, (const void*)fwd_kernel, 512, LDS_BYTES);
        if (per_cu < 1) { fprintf(stderr, "occupancy query returned %d\n", per_cu); per_cu = 1; }
        grid_blocks = cus * per_cu;
    }
    Params p{};
    p.x = (const float*)d_in[0]; p.mem = (const float*)d_in[1]; p.pre_g = (const float*)d_in[2]; p.w_in = (const float*)d_in[3]; p.sink = (const float*)d_in[4];
    p.mem_g = (const float*)d_in[5]; p.w_memkv = (const float*)d_in[6]; p.w_out = (const float*)d_in[7]; p.post_g = (const float*)d_in[8];
    p.out = (float*)d_out; p.ws = (unsigned char*)d_ws;
    void* args[] = {&p};
    hipError_t e = hipLaunchCooperativeKernel((const void*)fwd_kernel, dim3(grid_blocks), dim3(512), args, LDS_BYTES, stream);
    if (e != hipSuccess) fprintf(stderr, "cooperative launch failed: %s (grid %d)\n", hipGetErrorString(e), grid_blocks);
}
```

```cpp
#include <hip/hip_runtime.h>
#include <hip/hip_cooperative_groups.h>
#include <cstdio>
namespace cg = cooperative_groups;
namespace pg8 {
#define PG8_LAS __attribute__((address_space(3)))
typedef unsigned short bf16_t;
typedef short bf16x8 __attribute__((ext_vector_type(8)));
typedef float f32x4 __attribute__((ext_vector_type(4)));
typedef unsigned u32x4 __attribute__((ext_vector_type(4)));
constexpr int BM = 256, BK = 64, HALF = 128, HTB = HALF * BK * 2  , STAGE_BYTES = 8 * HTB, NXCD = 8, WGM = 8;

__host__ __device__ __forceinline__ int lds_byte(int r, int c) { const int st = (r >> 4) * 2 + (c >> 5), rr = r & 15, cc = c & 31, ob = rr * 64 + cc * 2; return st * 1024 + (ob ^ (((ob >> 9) & 1) << 5)); }
__host__ __device__ __forceinline__ void stage_rc(int b, int& R, int& C) { const int st = b / 1024, sb = b % 1024, swz = sb ^ (((sb >> 9) & 1) << 5); R = (st >> 1) * 16 + swz / 64; C = (st & 1) * 32 + (swz % 64) / 2; }
__host__ __device__ __forceinline__ int perm32(int rho) { const int n = rho >> 4, i = rho & 15; return 8 * (i >> 2) + 4 * n + (i & 3); }

struct Unit { int pm, pn; };
struct Gemm { const bf16_t* A; const bf16_t* Bt; int M, N, K; };
struct StaticOrder {
    int nM, nN, nwg, G, c;
    __host__ __device__ void init(int M, int N, int G_, int c_) { nM = M / BM; nN = N / BM; nwg = nM * nN; G = G_; c = c_; }
    __host__ __device__ bool next(int i, Unit& u) const {
        const long L = (long)i * G + c; if (L >= nwg) return false;
        int wgid = (int)L; { const int q = nwg / NXCD, r = nwg % NXCD, xcd = wgid % NXCD, off = wgid / NXCD; wgid = (xcd < r ? xcd * (q + 1) : r * (q + 1) + (xcd - r) * q) + off; }
        const int nig = WGM * nN, gid = wgid / nig, fm = gid * WGM, gsz = (nM - fm) < WGM ? (nM - fm) : WGM;
        u.pm = fm + ((wgid % nig) % gsz); u.pn = (wgid % nig) / gsz; return true;
    }
    __device__ __forceinline__ void a_ready(const Unit&) const {}
    __device__ __forceinline__ void done(const Unit&) const {}
};
__device__ __forceinline__ unsigned cvt_pk_bf16(float lo, float hi) { unsigned r; asm volatile("v_cvt_pk_bf16_f32 %0, %1, %2" : "=v"(r) : "v"(lo), "v"(hi)); return r; }
struct EpiF32 {
    static constexpr bool PERM = false, AFTER_DRAIN = false;
    float* C; int ldc; const float* bias;
    __device__ __forceinline__ void operator()(const f32x4 (&acc)[2][2][4][2], const Unit& u, int wr, int wc, int fr, int fq) const {
        const int row0 = u.pm * BM + wr * 64 + fr, col0 = u.pn * BM + wc * 32 + 4 * fq;
        f32x4 bv[2][2];
#pragma unroll
        for (int bj = 0; bj < 2; ++bj)
#pragma unroll
            for (int n = 0; n < 2; ++n) bv[bj][n] = bias ? *(const f32x4*)(bias + col0 + bj * HALF + n * 16) : (f32x4){0.f, 0.f, 0.f, 0.f};
#pragma unroll
        for (int ai = 0; ai < 2; ++ai)
#pragma unroll
            for (int m = 0; m < 4; ++m) { float* rowp = C + (size_t)(row0 + ai * HALF + m * 16) * ldc + col0;
#pragma unroll
                for (int bj = 0; bj < 2; ++bj)
#pragma unroll
                    for (int n = 0; n < 2; ++n) *(f32x4*)(rowp + bj * HALF + n * 16) = acc[ai][bj][m][n] + bv[bj][n]; }
    }
};
template <class Epi, class Sched, bool STAMP = false>
__device__ __forceinline__ void gemm_phase(PG8_LAS unsigned char* lds, const Gemm g, const Sched& S, const Epi& E, unsigned long long* stamps) {
    const int tid = threadIdx.x, wid = __builtin_amdgcn_readfirstlane(tid >> 6), lane = tid & 63, wr = wid >> 2, wc = wid & 3, fr = lane & 15, fq = lane >> 4;
    const int K = g.K, nt = K / BK;
#define PG8_STAMP() do {} while (0)
    unsigned voffA[2], voffB[2];
#pragma unroll
    for (int i = 0; i < 2; ++i) { int R, C; stage_rc(tid * 16 + i * 8192, R, C); const int Rb = Epi::PERM ? ((R & ~31) + perm32(R & 31)) : R;
        voffA[i] = (unsigned)(R * K + C) * 2u; voffB[i] = (unsigned)(Rb * K + C) * 2u; }
    const size_t kstep = (size_t)(BK * 2);
    const size_t hstep = (size_t)HALF * K * 2;
    const size_t tstep = 2 * hstep;
    const unsigned ldsw = (unsigned)wid * 1024u;
    const int aoff = lds_byte(wr * 64 + fr, fq * 8), boff = lds_byte(wc * 32 + fr, fq * 8);
#define PG8_SA(b, h) (((b) * 2 + (h)) * HTB)
#define PG8_SB(b, h) ((4 + (b) * 2 + (h)) * HTB)
#define PG8_STAGE(bufoff, gbase, voff) do { _Pragma("unroll") for (int _i = 0; _i < 2; ++_i) \
        __builtin_amdgcn_global_load_lds((const unsigned*)((const char*)(gbase) + (voff)[_i]), (PG8_LAS unsigned*)(lds + (bufoff) + ldsw + _i * 8192), 16, 0, 0); } while (0)
#define PG8_LDA(dst, b, h) do { _Pragma("unroll") for (int m = 0; m < 4; ++m) _Pragma("unroll") for (int k = 0; k < 2; ++k) dst[m][k] = *(const PG8_LAS bf16x8*)(lds + PG8_SA(b, h) + aoff + m * 2048 + k * 1024); } while (0)
#define PG8_LDB(dst, b, h) do { _Pragma("unroll") for (int n = 0; n < 2; ++n) _Pragma("unroll") for (int k = 0; k < 2; ++k) dst[n][k] = *(const PG8_LAS bf16x8*)(lds + PG8_SB(b, h) + boff + n * 2048 + k * 1024); } while (0)
#define PG8_MMA(ai, bj, At, Bt) do { __builtin_amdgcn_s_setprio(1); _Pragma("unroll") for (int m = 0; m < 4; ++m) _Pragma("unroll") for (int n = 0; n < 2; ++n) _Pragma("unroll") for (int k = 0; k < 2; ++k) \
        acc[ai][bj][m][n] = __builtin_amdgcn_mfma_f32_16x16x32_bf16(Bt[n][k], At[m][k], acc[ai][bj][m][n], 0, 0, 0); __builtin_amdgcn_s_setprio(0); } while (0)
#define PG8_WAIT_V(n) asm volatile("s_waitcnt vmcnt(" #n ")" ::: "memory")
#define PG8_WAIT_L(n) asm volatile("s_waitcnt lgkmcnt(" #n ")" ::: "memory")
#define PG8_BAR __builtin_amdgcn_s_barrier()
#define PG8_SCHED __builtin_amdgcn_sched_barrier(0)
    Unit cur, nxt; int ui = 0;
    if (!S.next(0, cur)) return;
    f32x4 acc[2][2][4][2];
#pragma unroll
    for (int a = 0; a < 2; ++a)
#pragma unroll
        for (int b = 0; b < 2; ++b)
#pragma unroll
            for (int m = 0; m < 4; ++m)
#pragma unroll
                for (int n = 0; n < 2; ++n) acc[a][b][m][n] = (f32x4){0.f, 0.f, 0.f, 0.f};
    bf16x8 At[4][2], B0[2][2], B1[2][2];
    const char* cA = (const char*)g.A + (size_t)cur.pm * tstep; const char* cB = (const char*)g.Bt + (size_t)cur.pn * tstep;
    S.a_ready(cur);
    PG8_STAGE(PG8_SB(0, 0), cB, voffB); PG8_STAGE(PG8_SA(0, 0), cA, voffA); PG8_STAGE(PG8_SB(0, 1), cB + hstep, voffB); PG8_STAGE(PG8_SA(0, 1), cA + hstep, voffA);
    if (wr == 1) PG8_BAR;
    PG8_WAIT_V(4); PG8_BAR;
    PG8_STAGE(PG8_SB(1, 0), cB + kstep, voffB); PG8_STAGE(PG8_SA(1, 0), cA + kstep, voffA); PG8_STAGE(PG8_SB(1, 1), cB + hstep + kstep, voffB);
    PG8_WAIT_V(6); PG8_BAR;
    PG8_STAMP();
    for (;;) {
        const bool has_next = S.next(ui + 1, nxt);
        const char* nA = has_next ? (const char*)g.A + (size_t)nxt.pm * tstep : cA; const char* nB = has_next ? (const char*)g.Bt + (size_t)nxt.pn * tstep : cB;
        for (int t = 0; t < nt; t += 2) {
            const bool last = (t == nt - 2);
            const char* a1 = cA + (size_t)(t + 1) * kstep;
            const char* a2 = last ? nA : cA + (size_t)(t + 2) * kstep; const char* b2 = last ? nB : cB + (size_t)(t + 2) * kstep;
            const char* a3 = a2 + kstep; const char* b3 = b2 + kstep;
            if (last && has_next) S.a_ready(nxt);
            PG8_LDB(B0, 0, 0); PG8_SCHED; PG8_LDA(At, 0, 0); PG8_STAGE(PG8_SA(1, 1), a1 + hstep, voffA);
            PG8_WAIT_L(8); PG8_BAR; PG8_WAIT_L(0); PG8_MMA(0, 0, At, B0); PG8_BAR; PG8_SCHED;
            PG8_LDB(B1, 0, 1); PG8_STAGE(PG8_SB(0, 0), b2, voffB);
            PG8_BAR; PG8_WAIT_L(0); PG8_MMA(0, 1, At, B1); PG8_BAR;
            PG8_LDA(At, 0, 1); PG8_STAGE(PG8_SA(0, 0), a2, voffA);
            PG8_BAR; PG8_WAIT_L(0); PG8_MMA(1, 0, At, B0); PG8_BAR; PG8_SCHED;
            PG8_STAGE(PG8_SB(0, 1), b2 + hstep, voffB);
            PG8_WAIT_V(6); PG8_BAR; PG8_MMA(1, 1, At, B1); PG8_BAR;
            PG8_LDB(B0, 1, 0); PG8_SCHED; PG8_LDA(At, 1, 0); PG8_STAGE(PG8_SA(0, 1), a2 + hstep, voffA);
            PG8_WAIT_L(8); PG8_BAR; PG8_WAIT_L(0); PG8_MMA(0, 0, At, B0); PG8_BAR; PG8_SCHED;
            PG8_LDB(B1, 1, 1); PG8_STAGE(PG8_SB(1, 0), b3, voffB);
            PG8_BAR; PG8_WAIT_L(0); PG8_MMA(0, 1, At, B1); PG8_BAR;
            PG8_LDA(At, 1, 1); PG8_STAGE(PG8_SA(1, 0), a3, voffA);
            PG8_BAR; PG8_WAIT_L(0); PG8_MMA(1, 0, At, B0); PG8_BAR; PG8_SCHED;
            PG8_STAGE(PG8_SB(1, 1), b3 + hstep, voffB);
            PG8_WAIT_V(6); PG8_BAR; PG8_MMA(1, 1, At, B1); PG8_BAR;
        }
        PG8_STAMP();
        if constexpr (!Epi::AFTER_DRAIN) { E(acc, cur, wr, wc, fr, fq); S.done(cur); }
        PG8_STAMP();
        if (!has_next) break;
#pragma unroll
        for (int a = 0; a < 2; ++a)
#pragma unroll
            for (int b = 0; b < 2; ++b)
#pragma unroll
                for (int m = 0; m < 4; ++m)
#pragma unroll
                    for (int n = 0; n < 2; ++n) acc[a][b][m][n] = (f32x4){0.f, 0.f, 0.f, 0.f};
        cur = nxt; cA = nA; cB = nB; ++ui;
    }
    PG8_WAIT_V(0);
    if (wr == 0) PG8_BAR;
    PG8_BAR;
    if constexpr (Epi::AFTER_DRAIN) { E.fused(acc, cur, wr, wc, fr, fq, lds, wid, lane); S.done(cur); }
    PG8_STAMP();
#undef PG8_STAMP
#undef PG8_SA
#undef PG8_SB
#undef PG8_STAGE
#undef PG8_LDA
#undef PG8_LDB
#undef PG8_MMA
#undef PG8_WAIT_V
#undef PG8_WAIT_L
#undef PG8_BAR
#undef PG8_SCHED
}
}
using pg8::bf16_t; using pg8::bf16x8; using pg8::f32x4; using pg8::u32x4; using pg8::Unit;
#define LAS __attribute__((address_space(3)))
typedef short s16x4 __attribute__((ext_vector_type(4)));
typedef float f32x16 __attribute__((ext_vector_type(16)));
typedef float f32x2 __attribute__((ext_vector_type(2)));
typedef __bf16 bf16x2_t __attribute__((ext_vector_type(2)));
typedef unsigned u32x2 __attribute__((ext_vector_type(2)));

constexpr int NTOK = 32768, SEQ = 8192, DM = 1024, DIN = 3072, MROWS = 32768 + 1024;
constexpr size_t OFF_U = 0, OFF_WINT = 69206016, OFF_WOUTT = 76546048, OFF_ROPE = 78643200, OFF_MKV = 79167488, OFF_CTR = 80216064,
                 OFF_Y = OFF_U  , OFF_PROJ = 147325184, OFF_Z = OFF_PROJ, OFF_BAR = 348651776, OFF_CNT = OFF_BAR + 16384, OFF_QCTR = OFF_CNT + 1024, OFF_PART = OFF_CNT + 8192;
#ifndef REP_ATTN
#define REP_ATTN 1
#endif
#ifndef REP_GIN
#define REP_GIN 1
#endif
#ifndef REP_MISC
#define REP_MISC 1
#endif
constexpr int LDS_BYTES = 159776;
constexpr int ST_ROWB = 136, ST_ML = 69632, ST_V = 73728, ST_VW = 10752, ST_K = 6144, ST_ITEM = 159744, ST_XB = 159760, VROWB = 192, KROWB = 144;

struct Params { const float *x, *mem, *pre_g, *w_in, *sink, *mem_g, *w_memkv, *w_out, *post_g; float* out; unsigned char* ws; };

__device__ __forceinline__ unsigned pack2(float lo, float hi) { f32x2 v; v.x = lo; v.y = hi; return __builtin_bit_cast(unsigned, __builtin_convertvector(v, bf16x2_t)); }
__device__ __forceinline__ float bflo(unsigned w) { return __uint_as_float(w << 16); }
__device__ __forceinline__ float bfhi(unsigned w) { return __uint_as_float(w & 0xffff0000u); }
__device__ __forceinline__ float wave_sum(float v) {
#pragma unroll
    for (int o = 32; o >= 1; o >>= 1) v += __shfl_xor(v, o);
    return v;
}

__device__ __forceinline__ void transpose_tile(const float* __restrict__ W, int N, bf16_t* __restrict__ WT, int task, int lane) {
    const int ntn = N >> 6, k0 = (task / ntn) * 64, n = (task % ntn) * 64 + lane;
    const float* src = W + (size_t)k0 * N + n;
    float v[64];
#pragma unroll
    for (int r = 0; r < 64; ++r) v[r] = __builtin_nontemporal_load(src + (size_t)r * N);
    bf16_t* dst = WT + (size_t)n * 1024 + k0;
#pragma unroll
    for (int q = 0; q < 8; ++q) {
        u32x4 w; w.x = pack2(v[8 * q], v[8 * q + 1]); w.y = pack2(v[8 * q + 2], v[8 * q + 3]); w.z = pack2(v[8 * q + 4], v[8 * q + 5]); w.w = pack2(v[8 * q + 6], v[8 * q + 7]);
        *(u32x4*)(dst + 8 * q) = w;
    }
}
__device__ __forceinline__ void phase_prep(const Params& p) {
    const int tid = threadIdx.x, lane = tid & 63, wid = tid >> 6;
    const int gw = blockIdx.x * 8 + wid, nw = gridDim.x * 8, gt = blockIdx.x * 512 + tid, nt = gridDim.x * 512;
    bf16_t* U = (bf16_t*)(p.ws + OFF_U);
    if (blockIdx.x == 0 && tid < 2) ((unsigned*)(p.ws + OFF_CTR))[tid * 8] = 0u;
    for (int row = gw; row < MROWS; row += 2 * nw) {
        const int row2 = row + nw < MROWS ? row + nw : row;
        const float* src = row < NTOK ? p.x + (size_t)row * DM : p.mem + (size_t)(row - NTOK) * DM;
        const float* src2 = row2 < NTOK ? p.x + (size_t)row2 * DM : p.mem + (size_t)(row2 - NTOK) * DM;
        const float* g = row < NTOK ? p.pre_g : p.mem_g;
        const float* g2 = row2 < NTOK ? p.pre_g : p.mem_g;
        f32x4 v[4], w2[4];
#pragma unroll
        for (int i = 0; i < 4; ++i) { v[i] = __builtin_nontemporal_load((const f32x4*)(src + i * 256 + lane * 4)); w2[i] = __builtin_nontemporal_load((const f32x4*)(src2 + i * 256 + lane * 4)); }
        float ss = 0.f, ss2 = 0.f;
#pragma unroll
        for (int i = 0; i < 4; ++i) { ss += v[i][0] * v[i][0] + v[i][1] * v[i][1] + v[i][2] * v[i][2] + v[i][3] * v[i][3];
                                      ss2 += w2[i][0] * w2[i][0] + w2[i][1] * w2[i][1] + w2[i][2] * w2[i][2] + w2[i][3] * w2[i][3]; }
        ss = wave_sum(ss); ss2 = wave_sum(ss2);
        const float r = rsqrtf(ss * (1.0f / 1024.0f) + 1e-6f), r2 = rsqrtf(ss2 * (1.0f / 1024.0f) + 1e-6f);
#pragma unroll
        for (int i = 0; i < 4; ++i) {
            const f32x4 gg = *(const f32x4*)(g + i * 256 + lane * 4), gg2 = *(const f32x4*)(g2 + i * 256 + lane * 4);
            u32x2 w; w.x = pack2(v[i][0] * r * gg[0], v[i][1] * r * gg[1]); w.y = pack2(v[i][2] * r * gg[2], v[i][3] * r * gg[3]);
            *(u32x2*)(U + (size_t)row * DM + i * 256 + lane * 4) = w;
            u32x2 y; y.x = pack2(w2[i][0] * r2 * gg2[0], w2[i][1] * r2 * gg2[1]); y.y = pack2(w2[i][2] * r2 * gg2[2], w2[i][3] * r2 * gg2[3]);
            *(u32x2*)(U + (size_t)row2 * DM + i * 256 + lane * 4) = y;
        }
    }
    bf16_t* WinT = (bf16_t*)(p.ws + OFF_WINT);
    for (int task = gw; task < 768 + 128 + 256; task += nw) {
        if (task < 768) transpose_tile(p.w_in, 3072, WinT, task, lane);
        else if (task < 896) transpose_tile(p.w_memkv, 512, WinT + (size_t)3072 * 1024, task - 768, lane);
        else transpose_tile(p.w_out, 1024, (bf16_t*)(p.ws + OFF_WOUTT), task - 896, lane);
    }
    float* rope = (float*)(p.ws + OFF_ROPE);
    for (int it = gt; it < SEQ * 8; it += nt) {
        const int pos = it >> 3, i = it & 7;
        const float inv = i == 0 ? 1.0f : i == 1 ? 0x1.8d275ep-3f : i == 2 ? 0x1.341190p-5f : i == 3 ? 0x1.ddee9cp-8f : i == 4 ? 0x1.72ba44p-10f : i == 5 ? 0x1.1f91f0p-12f : i == 6 ? 0x1.be2188p-15f : 0x1.5a0f4ep-17f;
        const float ang = (float)pos * inv;
        rope[pos * 16 + i] = cosf(ang); rope[pos * 16 + 8 + i] = sinf(ang);
    }
}

struct MemUnit {
    int L;
    __device__ bool next(int i, Unit& u) const { if (i != 0) return false; u.pm = 128 + (L >> 1); u.pn = 12 + (L & 1); return true; }
    __device__ __forceinline__ void a_ready(const Unit&) const {}
    __device__ __forceinline__ void done(const Unit&) const {}
};
struct EpiIn {
    static constexpr bool PERM = true, AFTER_DRAIN = false;
    bf16_t* proj; bf16_t* mkv; const float* rope;
    __device__ __forceinline__ void operator()(const f32x4 (&acc)[2][2][4][2], const Unit& u, int wr, int wc, int fr, int fq) const {
        if (u.pm >= 128) {
            const int row0 = (u.pm - 128) * 256 + wr * 64 + fr, col0 = (u.pn - 12) * 256 + wc * 32 + 8 * fq;
#pragma unroll
            for (int ai = 0; ai < 2; ++ai)
#pragma unroll
                for (int m = 0; m < 4; ++m) { bf16_t* rowp = mkv + (size_t)(row0 + ai * 128 + m * 16) * 512 + col0;
#pragma unroll
                    for (int bj = 0; bj < 2; ++bj) { const f32x4 v0 = acc[ai][bj][m][0], v1 = acc[ai][bj][m][1];
                        u32x4 w; w.x = pack2(v0[0], v0[1]); w.y = pack2(v0[2], v0[3]); w.z = pack2(v1[0], v1[1]); w.w = pack2(v1[2], v1[3]);
                        *(u32x4*)(rowp + bj * 128) = w; } }
            return;
        }
        const int row0 = u.pm * 256 + wr * 64 + fr;
        bf16_t* __restrict__ projr = proj; const float* __restrict__ roper = rope;
#pragma unroll
        for (int bj = 0; bj < 2; ++bj) {
            const int cg0 = u.pn * 256 + bj * 128 + wc * 32;
            const float scale = (cg0 < 384 || (cg0 >= 1024 && cg0 < 1408) || (cg0 >= 2560 && cg0 < 2816)) ? 0.18033688011112042f : 1.0f;
            const bool rope_on = (cg0 < 512 || (cg0 >= 1024 && cg0 < 1792)) && ((cg0 & 63) == 0);
#pragma unroll
            for (int ai = 0; ai < 2; ++ai)
#pragma unroll
                for (int m = 0; m < 4; ++m) {
                    const int row = row0 + ai * 128 + m * 16;
                    f32x4 v0 = acc[ai][bj][m][0], v1 = acc[ai][bj][m][1];
                    if (rope_on) {
                        f32x4 p0, p1;
#pragma unroll
                        for (int j = 0; j < 4; ++j) { p0[j] = __shfl_xor(v0[j], 16); p1[j] = __shfl_xor(v1[j], 16); }
                        if (fq < 2) {
                            const float* cs = roper + (size_t)(row & (SEQ - 1)) * 16;
                            const f32x4 c0 = *(const f32x4*)(cs), c1 = *(const f32x4*)(cs + 4), s0 = *(const f32x4*)(cs + 8), s1 = *(const f32x4*)(cs + 12);
                            const float sg = fq == 0 ? -1.0f : 1.0f;
                            v0 = v0 * c0 + sg * (p0 * s0); v1 = v1 * c1 + sg * (p1 * s1);
                        }
                    }
                    v0 *= scale; v1 *= scale;
                    u32x4 w; w.x = pack2(v0[0], v0[1]); w.y = pack2(v0[2], v0[3]); w.z = pack2(v1[0], v1[1]); w.w = pack2(v1[2], v1[3]);
                    *(u32x4*)(projr + ((size_t)(cg0 >> 6) * NTOK + row) * 64 + (cg0 & 63) + 8 * fq) = w;
                }
        }
    }
};

struct OneUnit {
    pg8::StaticOrder so; int round;
    __device__ bool next(int i, Unit& u) const { return i == 0 ? so.next(round, u) : false; }
    __device__ __forceinline__ void a_ready(const Unit&) const {}
    __device__ __forceinline__ void done(const Unit&) const {}
};
struct EpiOutFused {
    static constexpr bool PERM = false, AFTER_DRAIN = true;
    const float* x; const float* g; float* out; float* part; unsigned* cnt;
    __device__ __forceinline__ void fused(const f32x4 (&acc)[2][2][4][2], const Unit& u, int wr, int wc, int fr, int fq, LAS unsigned char*, int, int) const {
        const int row0 = u.pm * 256 + wr * 64 + fr, col0 = u.pn * 256 + wc * 32 + 4 * fq;
#pragma unroll
        for (int ai = 0; ai < 2; ++ai)
#pragma unroll
            for (int m = 0; m < 4; ++m) {
                float ss = 0.f;
#pragma unroll
                for (int bj = 0; bj < 2; ++bj)
#pragma unroll
                    for (int n = 0; n < 2; ++n) { const f32x4 v = acc[ai][bj][m][n]; ss += v[0] * v[0] + v[1] * v[1] + v[2] * v[2] + v[3] * v[3]; }
                ss += __shfl_xor(ss, 16); ss += __shfl_xor(ss, 32);
                if (fq == 0) __hip_atomic_store(part + (size_t)(row0 + ai * 128 + m * 16) * 16 + u.pn * 4 + wc, ss, __ATOMIC_RELAXED, __HIP_MEMORY_SCOPE_AGENT);
            }
        asm volatile("s_waitcnt vmcnt(0)" ::: "memory");
        __syncthreads();
        if (threadIdx.x == 0) {
            __hip_atomic_fetch_add(cnt + u.pm, 1u, __ATOMIC_RELAXED, __HIP_MEMORY_SCOPE_AGENT);
            unsigned sp = 0; while (__hip_atomic_load(cnt + u.pm, __ATOMIC_RELAXED, __HIP_MEMORY_SCOPE_AGENT) < 4u && ++sp < (1u << 22)) __builtin_amdgcn_s_sleep(2);
        }
        f32x4 gv[2][2];
#pragma unroll
        for (int bj = 0; bj < 2; ++bj)
#pragma unroll
            for (int n = 0; n < 2; ++n) gv[bj][n] = *(const f32x4*)(g + col0 + bj * 128 + n * 16);
        __syncthreads();
        asm volatile("" ::: "memory");
        const float* __restrict__ xr = x; float* __restrict__ outr = out;
        float rr[2][4];
#pragma unroll
        for (int ai = 0; ai < 2; ++ai)
#pragma unroll
            for (int m = 0; m < 4; ++m) {
                const float* pp = part + (size_t)(row0 + ai * 128 + m * 16) * 16 + 4 * fq;
                float t = 0.f;
#pragma unroll
                for (int j = 0; j < 4; ++j) t += __hip_atomic_load(pp + j, __ATOMIC_RELAXED, __HIP_MEMORY_SCOPE_AGENT);
                rr[ai][m] = t;
            }
#pragma unroll
        for (int q = 0; q < 4; ++q) {
            const int ai = q >> 1, m0 = (q & 1) * 2;
            f32x4 xx[2][2][2];
#pragma unroll
            for (int mm = 0; mm < 2; ++mm)
#pragma unroll
                for (int bj = 0; bj < 2; ++bj)
#pragma unroll
                    for (int n = 0; n < 2; ++n) xx[mm][bj][n] = *(const f32x4*)(xr + (size_t)(row0 + ai * 128 + (m0 + mm) * 16) * DM + col0 + bj * 128 + n * 16);
            asm volatile("" ::: "memory");
#pragma unroll
            for (int mm = 0; mm < 2; ++mm) {
                const int m = m0 + mm;
                float t = rr[ai][m];
                t += __shfl_xor(t, 16); t += __shfl_xor(t, 32);
                const float r = rsqrtf(t * (1.0f / 1024.0f) + 1e-6f);
                const size_t off = (size_t)(row0 + ai * 128 + m * 16) * DM + col0;
#pragma unroll
                for (int bj = 0; bj < 2; ++bj)
#pragma unroll
                    for (int n = 0; n < 2; ++n) __builtin_nontemporal_store(xx[mm][bj][n] + acc[ai][bj][m][n] * r * gv[bj][n], (f32x4*)(outr + off + bj * 128 + n * 16));
            }
        }
    }
};

__device__ __forceinline__ float xhalf_max(float x) { const auto r = __builtin_amdgcn_permlane32_swap(__float_as_uint(x), __float_as_uint(x), false, false); return fmaxf(__uint_as_float(r[0]), __uint_as_float(r[1])); }
__device__ __forceinline__ float xhalf_sum(float x) { const auto r = __builtin_amdgcn_permlane32_swap(__float_as_uint(x), __float_as_uint(x), false, false); return __uint_as_float(r[0]) + __uint_as_float(r[1]); }
__device__ __forceinline__ int crow(int r, int h) { return (r & 3) + 8 * (r >> 2) + 4 * h; }
#define MFMA32(a, b, c) __builtin_amdgcn_mfma_f32_32x32x16_bf16((a), (b), (c), 0, 0, 0)

constexpr int PD = 1;
template <int MODE, int NKT>
__device__ __forceinline__ void attn_core(const bf16_t* __restrict__ qtile, const int qstride, const bf16_t* __restrict__ kb, const bf16_t* __restrict__ vb, const int ld, const int res, const int dil,
                                          const int kidx0, const int nq, const int maxd, float& m, float& l, f32x16& o0, f32x16& o1, LAS unsigned char* vl, const int lane) {
    const int c = lane & 31, h = lane >> 5;
    const int q4 = (lane & 15) >> 2, p4 = lane & 3, g2 = (lane >> 4) & 1;
    LAS unsigned char* trb = vl + (4 * h + q4) * VROWB + 32 * g2 + 8 * p4;
    const int vr = lane >> 3, vc = lane & 7;
    LAS unsigned char* vw = vl + vr * VROWB + vc * 16;
    LAS unsigned char* kw = vl + ST_K + vr * KROWB + vc * 16;
    LAS unsigned char* krd = vl + ST_K + c * KROWB + 16 * h;
    u32x4 kreg[PD][4]; u32x4 vreg[PD][4];
    const long tstep = (long)32 * dil * ld, istep = (long)8 * dil * ld;
    const bf16_t* kp = kb + ((long)(res + dil * (kidx0 + vr)) * ld + vc * 8);
    const bf16_t* vp = vb + ((long)(res + dil * (kidx0 + vr)) * ld + vc * 8);
#define LOAD_TILE(kt, sl) do { \
        _Pragma("unroll") for (int i = 0; i < 4; ++i) { \
            kreg[sl][i] = *(const u32x4*)(kp + (kt) * tstep + i * istep); vreg[sl][i] = *(const u32x4*)(vp + (kt) * tstep + i * istep); } } while (0)
#pragma unroll
    for (int t = 0; t < PD; ++t) if (t < NKT) LOAD_TILE(t, t);
    bf16x8 qf[4];
    {
        u32x4 qreg[4];
#pragma unroll
        for (int i = 0; i < 4; ++i) qreg[i] = *(const u32x4*)(qtile + (size_t)(vr + 8 * i) * qstride + vc * 8);
#pragma unroll
        for (int i = 0; i < 4; ++i) *(LAS u32x4*)(kw + i * 8 * KROWB) = qreg[i];
#pragma unroll
        for (int kk = 0; kk < 4; ++kk) qf[kk] = *(LAS bf16x8*)(krd + 32 * kk);
    }
    asm volatile("" ::: "memory");
#pragma unroll 1
    for (int kt0 = 0; kt0 < NKT; kt0 += PD) {
#pragma unroll
      for (int sl = 0; sl < PD; ++sl) {
        const int kt = kt0 + sl;
        if (kt < NKT) {
#pragma unroll
        for (int i = 0; i < 4; ++i) { *(LAS u32x4*)(kw + i * 8 * KROWB) = kreg[sl][i]; *(LAS u32x4*)(vw + i * 8 * VROWB) = vreg[sl][i]; }
        f32x16 s;
#pragma unroll
        for (int r = 0; r < 16; ++r) s[r] = 0.f;
#pragma unroll
        for (int kk = 0; kk < 4; ++kk) { const bf16x8 kfr = *(LAS bf16x8*)(krd + 32 * kk); s = MFMA32(kfr, qf[kk], s); }
        asm volatile("" ::: "memory");
        if (kt + PD < NKT) { LOAD_TILE(kt + PD, sl); }
        asm volatile("" ::: "memory");
        if (MODE != 2 && (kt == 0 || kt == NKT - 1)) {
            const int nkb = kidx0 + 32 * kt;
#pragma unroll
            for (int r = 0; r < 16; ++r) { const int nk = nkb + crow(r, h), dist = nq - nk; s[r] = (nk >= 0 && dist >= 0 && dist <= maxd) ? s[r] : -INFINITY; }
        } else if (MODE != 2) {
            const int nkb = kidx0 + 32 * kt;
            if (nkb < 0) {
#pragma unroll
                for (int r = 0; r < 16; ++r) { const int nk = nkb + crow(r, h); s[r] = nk >= 0 ? s[r] : -INFINITY; }
            }
        }
        float mx = s[0];
#pragma unroll
        for (int r = 1; r < 16; ++r) mx = fmaxf(mx, s[r]);
        mx = xhalf_max(mx);
        if (__builtin_amdgcn_ballot_w64(mx > m + 8.0f) != 0ull) {
            const float mnew = fmaxf(m, mx);
            const float alpha = mnew == -INFINITY ? 1.0f : __builtin_amdgcn_exp2f(m - mnew);
            l *= alpha; o0 *= alpha; o1 *= alpha; m = mnew;
        }
        const float mref = m == -INFINITY ? 0.f : m;
        float rs = 0.f;
#pragma unroll
        for (int r = 0; r < 16; ++r) { s[r] = __builtin_amdgcn_exp2f(s[r] - mref); rs += s[r]; }
        l += rs;
        bf16x8 pf[2];
#pragma unroll
        for (int s2 = 0; s2 < 2; ++s2) { u32x4 w; w.x = pack2(s[8 * s2], s[8 * s2 + 1]); w.y = pack2(s[8 * s2 + 2], s[8 * s2 + 3]); w.z = pack2(s[8 * s2 + 4], s[8 * s2 + 5]); w.w = pack2(s[8 * s2 + 6], s[8 * s2 + 7]);
            pf[s2] = __builtin_bit_cast(bf16x8, w); }
#pragma unroll
        for (int s2 = 0; s2 < 2; ++s2) {
            const s16x4 a0 = __builtin_amdgcn_ds_read_tr16_b64_v4i16((LAS s16x4*)(trb + (16 * s2) * VROWB));
            const s16x4 a1 = __builtin_amdgcn_ds_read_tr16_b64_v4i16((LAS s16x4*)(trb + (16 * s2 + 8) * VROWB));
            const s16x4 b0 = __builtin_amdgcn_ds_read_tr16_b64_v4i16((LAS s16x4*)(trb + (16 * s2) * VROWB + 64));
            const s16x4 b1 = __builtin_amdgcn_ds_read_tr16_b64_v4i16((LAS s16x4*)(trb + (16 * s2 + 8) * VROWB + 64));
            const bf16x8 va = __builtin_shufflevector(a0, a1, 0, 1, 2, 3, 4, 5, 6, 7), vbv = __builtin_shufflevector(b0, b1, 0, 1, 2, 3, 4, 5, 6, 7);
            o0 = MFMA32(va, pf[s2], o0);
            o1 = MFMA32(vbv, pf[s2], o1);
        }
        }
      }
    }
#undef LOAD_TILE
}

template <int NKT>
__device__ __forceinline__ void attn_core_img(const bf16_t* __restrict__ qrow, LAS unsigned char* kimg, LAS unsigned char* vimg, float& m, float& l, f32x16& o0, f32x16& o1, const int lane) {
    const int c = lane & 31, h = lane >> 5;
    const int q4 = (lane & 15) >> 2, p4 = lane & 3, g2 = (lane >> 4) & 1;
    LAS unsigned char* trb = vimg + (4 * h + q4) * VROWB + 32 * g2 + 8 * p4;
    LAS unsigned char* krd = kimg + c * KROWB + 16 * h;
    bf16x8 qf[4];
#pragma unroll
    for (int kk = 0; kk < 4; ++kk) qf[kk] = *(const bf16x8*)(qrow + 16 * kk + 8 * h);
#pragma unroll 1
    for (int kt = 0; kt < NKT; ++kt) {
        f32x16 s;
#pragma unroll
        for (int r = 0; r < 16; ++r) s[r] = 0.f;
#pragma unroll
        for (int kk = 0; kk < 4; ++kk) { const bf16x8 kfr = *(LAS bf16x8*)(krd + kt * 32 * KROWB + 32 * kk); s = MFMA32(kfr, qf[kk], s); }
        float mx = s[0];
#pragma unroll
        for (int r = 1; r < 16; ++r) mx = fmaxf(mx, s[r]);
        mx = xhalf_max(mx);
        if (__builtin_amdgcn_ballot_w64(mx > m + 8.0f) != 0ull) {
            const float mnew = fmaxf(m, mx);
            const float alpha = mnew == -INFINITY ? 1.0f : __builtin_amdgcn_exp2f(m - mnew);
            l *= alpha; o0 *= alpha; o1 *= alpha; m = mnew;
        }
        const float mref = m == -INFINITY ? 0.f : m;
        float rs = 0.f;
#pragma unroll
        for (int r = 0; r < 16; ++r) { s[r] = __builtin_amdgcn_exp2f(s[r] - mref); rs += s[r]; }
        l += rs;
        bf16x8 pf[2];
#pragma unroll
        for (int s2 = 0; s2 < 2; ++s2) { u32x4 w; w.x = pack2(s[8 * s2], s[8 * s2 + 1]); w.y = pack2(s[8 * s2 + 2], s[8 * s2 + 3]); w.z = pack2(s[8 * s2 + 4], s[8 * s2 + 5]); w.w = pack2(s[8 * s2 + 6], s[8 * s2 + 7]);
            pf[s2] = __builtin_bit_cast(bf16x8, w); }
        LAS unsigned char* tb = trb + kt * 32 * VROWB;
#pragma unroll
        for (int s2 = 0; s2 < 2; ++s2) {
            const s16x4 a0 = __builtin_amdgcn_ds_read_tr16_b64_v4i16((LAS s16x4*)(tb + (16 * s2) * VROWB));
            const s16x4 a1 = __builtin_amdgcn_ds_read_tr16_b64_v4i16((LAS s16x4*)(tb + (16 * s2 + 8) * VROWB));
            const s16x4 b0 = __builtin_amdgcn_ds_read_tr16_b64_v4i16((LAS s16x4*)(tb + (16 * s2) * VROWB + 64));
            const s16x4 b1 = __builtin_amdgcn_ds_read_tr16_b64_v4i16((LAS s16x4*)(tb + (16 * s2 + 8) * VROWB + 64));
            const bf16x8 va = __builtin_shufflevector(a0, a1, 0, 1, 2, 3, 4, 5, 6, 7), vbv = __builtin_shufflevector(b0, b1, 0, 1, 2, 3, 4, 5, 6, 7);
            o0 = MFMA32(va, pf[s2], o0);
            o1 = MFMA32(vbv, pf[s2], o1);
        }
    }
}

__device__ __forceinline__ float silu(float g) { return g * __builtin_amdgcn_rcpf(1.0f + __expf(-g)); }
__device__ __forceinline__ void attn_finalize(const f32x16& o0, const f32x16& o1, float l, const bf16_t* __restrict__ gtile, bf16_t* __restrict__ ytile, LAS unsigned char* vl, int lane) {
    const int c = lane & 31, h = lane >> 5, vr = lane >> 3, vc = lane & 7;
    u32x4 gv[4];
#pragma unroll
    for (int i = 0; i < 4; ++i) gv[i] = *(const u32x4*)(gtile + (size_t)(vr + 8 * i) * 64 + vc * 8);
    const float inv = __builtin_amdgcn_rcpf(l);
#pragma unroll
    for (int cc = 0; cc < 2; ++cc)
#pragma unroll
        for (int g = 0; g < 4; ++g) {
            const f32x16& o = cc ? o1 : o0;
            u32x2 w; w.x = pack2(o[4 * g] * inv, o[4 * g + 1] * inv); w.y = pack2(o[4 * g + 2] * inv, o[4 * g + 3] * inv);
            *(LAS u32x2*)(vl + c * 136 + (32 * cc + 8 * g + 4 * h) * 2) = w;
        }
#pragma unroll
    for (int i = 0; i < 4; ++i) {
        const int r = vr + 8 * i;
        const u32x2 lo = *(LAS u32x2*)(vl + r * 136 + vc * 16), hi = *(LAS u32x2*)(vl + r * 136 + vc * 16 + 8);
        const unsigned ov[4] = {lo.x, lo.y, hi.x, hi.y};
        u32x4 w;
#pragma unroll
        for (int j = 0; j < 4; ++j) { const float y0 = bflo(ov[j]) * silu(bflo(gv[i][j])), y1 = bfhi(ov[j]) * silu(bfhi(gv[i][j])); w[j] = pack2(y0, y1); }
        *(u32x4*)(ytile + (size_t)r * DM + vc * 8) = w;
    }
}

__device__ __forceinline__ void phase_attn(const Params& p, LAS unsigned char* lds, int rep, int item_lo, int item_hi, unsigned xcc) {
    const bf16_t* proj = (const bf16_t*)(p.ws + OFF_PROJ); const bf16_t* mkv = (const bf16_t*)(p.ws + OFF_MKV); bf16_t* Y = (bf16_t*)(p.ws + OFF_Y);
    unsigned* ctr = (unsigned*)(p.ws + OFF_CTR) + rep * 8;
    const int tid = threadIdx.x, lane = tid & 63, wid = tid >> 6, c = lane & 31, h = lane >> 5;
    LAS unsigned char* vl = lds + ST_V + wid * ST_VW;
    LAS int* item_s = (LAS int*)(lds + ST_ITEM);
    unsigned* memflag = (unsigned*)(p.ws + OFF_CNT) + 192;
    if (rep == 0 && blockIdx.x < 8) {
        pg8::Gemm g; g.A = (const bf16_t*)(p.ws + OFF_U); g.Bt = (const bf16_t*)(p.ws + OFF_WINT); g.M = NTOK; g.N = DIN; g.K = DM;
        MemUnit S; S.L = (int)blockIdx.x;
        EpiIn E; E.proj = (bf16_t*)(p.ws + OFF_PROJ); E.mkv = (bf16_t*)(p.ws + OFF_MKV); E.rope = (const float*)(p.ws + OFF_ROPE);
        pg8::gemm_phase<EpiIn, MemUnit, false>(lds, g, S, E, nullptr);
        asm volatile("s_waitcnt vmcnt(0)" ::: "memory");
        __syncthreads();
        if (tid == 0) { __threadfence(); __hip_atomic_fetch_add(memflag, 1u, __ATOMIC_RELAXED, __HIP_MEMORY_SCOPE_AGENT); }
    }
    unsigned* qctr = (unsigned*)(p.ws + OFF_QCTR) + rep * 8 * 64;
    int dq = 0;
    for (int itn = 0;; ++itn) {
        if (tid == 0) {
            int code = -1;
            while (dq < 8) {
                const int q_ = (int)((xcc + (unsigned)dq) & 7u);
                if (__hip_atomic_load(qctr + q_ * 64, __ATOMIC_RELAXED, __HIP_MEMORY_SCOPE_AGENT) < 128u) {
                    const int j_ = (int)atomicAdd(qctr + q_ * 64, 1u);
                    if (j_ < 128) { code = q_ * 128 + j_; break; }
                }
                ++dq;
            }
            item_s[itn & 1] = code;
        }
        __syncthreads();
        const int code = __builtin_amdgcn_readfirstlane(item_s[itn & 1]);
        if (code < 0) break;
        const int qi = code >> 7, j = code & 127;
        int item;
        if (j < 48) { const int pair = qi + 8 * (j >> 4), b_ = pair / 6, hd = pair - b_ * 6; item = (b_ * 16 + (j & 15)) * 6 + hd; }
        else if (j < 96) { const int jj = j - 48, b_ = qi >> 1, kvh_ = qi & 1, stl = jj / 3, g_ = jj - stl * 3; item = 640 + (b_ * 16 + stl) * 6 + kvh_ * 3 + g_; }
        else { const int jj = j - 96, pair = qi + 8 * (jj >> 4), b_ = pair >> 2, hd = pair & 3; item = 384 + (b_ * 16 + (jj & 15)) * 4 + hd; }
        if (item < item_lo || item >= item_hi) continue;
        if (wid >= 4) __builtin_amdgcn_s_sleep(12);
        if (item < 384) {
            const int st = item / 6, head = item - st * 6, b = st >> 4, t0 = (st & 15) * 512;
            const size_t hb = (size_t)b * SEQ * 64;
            const bf16_t* qh_ = proj + (size_t)(16 + head) * NTOK * 64 + hb; const bf16_t* kh_ = proj + (size_t)(22 + head) * NTOK * 64 + hb;
            const bf16_t* vh_ = proj + (size_t)(28 + head) * NTOK * 64 + hb; const bf16_t* gh_ = proj + (size_t)(34 + head) * NTOK * 64 + hb;
#pragma unroll 1
            for (int pass = 0; pass < 3; ++pass) {
                const int dil = pass == 0 ? 16 : (pass == 1 ? 4 : 1);
#pragma unroll 1
                for (int su = wid; su < 16; su += 8) {
                    int res, n0;
                    if (pass == 0) { res = su; n0 = t0 >> 4; } else if (pass == 1) { res = su & 3; n0 = (t0 >> 2) + 32 * (su >> 2); } else { res = 0; n0 = t0 + 32 * su; }
                    const int nq = n0 + c, posq = res + dil * nq, tokl = posq - t0, rowp = tokl ^ ((tokl >> 4) & 15);
                    LAS unsigned char* so = lds + rowp * ST_ROWB + 8 * h;
                    LAS float* sml = (LAS float*)(lds + ST_ML + rowp * 8);
                    float m, l; f32x16 o0, o1;
                    if (pass == 0) { m = -INFINITY; l = 0.f;
#pragma unroll
                        for (int r = 0; r < 16; ++r) { o0[r] = 0.f; o1[r] = 0.f; }
                    } else {
                        m = sml[0]; l = h == 0 ? sml[1] : 0.f;
#pragma unroll
                        for (int g = 0; g < 4; ++g) {
                            const u32x2 a = *(LAS u32x2*)(so + 16 * g), bb = *(LAS u32x2*)(so + 64 + 16 * g);
                            o0[4 * g] = bflo(a.x); o0[4 * g + 1] = bfhi(a.x); o0[4 * g + 2] = bflo(a.y); o0[4 * g + 3] = bfhi(a.y);
                            o1[4 * g] = bflo(bb.x); o1[4 * g + 1] = bfhi(bb.x); o1[4 * g + 2] = bflo(bb.y); o1[4 * g + 3] = bfhi(bb.y);
                        }
                    }
                    attn_core<1, 5>(qh_ + (size_t)(res + dil * n0) * 64, 64 * dil, kh_, vh_, 64, res, dil, n0 - 128, nq, 128, m, l, o0, o1, vl, lane);
                    l = xhalf_sum(l);
                    if (pass < 2) {
                        if (h == 0) { sml[0] = m; sml[1] = l; }
#pragma unroll
                        for (int g = 0; g < 4; ++g) {
                            u32x2 a, bb; a.x = pack2(o0[4 * g], o0[4 * g + 1]); a.y = pack2(o0[4 * g + 2], o0[4 * g + 3]); bb.x = pack2(o1[4 * g], o1[4 * g + 1]); bb.y = pack2(o1[4 * g + 2], o1[4 * g + 3]);
                            *(LAS u32x2*)(so + 16 * g) = a; *(LAS u32x2*)(so + 64 + 16 * g) = bb;
                        }
                    } else {
                        attn_finalize(o0, o1, l, gh_ + (size_t)n0 * 64, Y + ((size_t)b * SEQ + n0) * DM + 384 + head * 64, vl, lane);
                    }
                }
                if (pass < 2) __syncthreads();
            }
        } else if (item < 640) {
            const int idx = item - 384, st = idx >> 2, head = idx & 3, b = st >> 4, t0 = (st & 15) * 512;
            if (tid == 0) { unsigned sp = 0; while (__hip_atomic_load(memflag, __ATOMIC_RELAXED, __HIP_MEMORY_SCOPE_AGENT) < 8u && ++sp < (1u << 22)) __builtin_amdgcn_s_sleep(2); }
            __syncthreads();
            __builtin_amdgcn_fence(__ATOMIC_ACQUIRE, "agent");
            const bf16_t* kb = mkv + (size_t)b * 256 * 512 + head * 64;
            LAS unsigned char* kimg = lds + ST_V; LAS unsigned char* vimg = lds + ST_V + 256 * KROWB;
            {
                u32x4 kk_[4], vv_[4];
#pragma unroll
                for (int i = 0; i < 4; ++i) { const int ch = tid + 512 * i, row = ch >> 3, vc_ = ch & 7;
                    kk_[i] = *(const u32x4*)(kb + (size_t)row * 512 + vc_ * 8); vv_[i] = *(const u32x4*)(kb + 256 + (size_t)row * 512 + vc_ * 8); }
#pragma unroll
                for (int i = 0; i < 4; ++i) { const int ch = tid + 512 * i, row = ch >> 3, vc_ = ch & 7;
                    *(LAS u32x4*)(kimg + row * KROWB + vc_ * 16) = kk_[i]; *(LAS u32x4*)(vimg + row * VROWB + vc_ * 16) = vv_[i]; }
            }
            __syncthreads();
            LAS unsigned char* vfin = lds + wid * 4608;
#pragma unroll 1
            for (int su = wid; su < 16; su += 8) {
                const size_t row0 = (size_t)b * SEQ + t0 + 32 * su;
                float m = -INFINITY, l = 0.f; f32x16 o0, o1;
#pragma unroll
                for (int r = 0; r < 16; ++r) { o0[r] = 0.f; o1[r] = 0.f; }
                attn_core_img<8>(proj + ((size_t)(40 + head) * NTOK + row0 + c) * 64, kimg, vimg, m, l, o0, o1, lane);
                l = xhalf_sum(l);
                attn_finalize(o0, o1, l, proj + ((size_t)(44 + head) * NTOK + row0) * 64, Y + row0 * DM + 768 + head * 64, vfin, lane);
            }
        } else {
            const int idx = item - 640, st = idx / 6, qh = idx - st * 6, kvh = qh / 3, b = st >> 4, t0 = (st & 15) * 512;
            const size_t hb = (size_t)b * SEQ * 64;
            const bf16_t* qh_ = proj + (size_t)qh * NTOK * 64 + hb; const bf16_t* kh_ = proj + (size_t)(6 + kvh) * NTOK * 64 + hb;
            const bf16_t* vh_ = proj + (size_t)(8 + kvh) * NTOK * 64 + hb; const bf16_t* gh_ = proj + (size_t)(10 + qh) * NTOK * 64 + hb;
            const float sink = p.sink[qh] * 1.4426950408889634f;
#pragma unroll 1
            for (int su = wid; su < 16; su += 8) {
                const int n0 = t0 + 32 * su, nq = n0 + c;
                float m = sink, l = h == 0 ? 1.0f : 0.f; f32x16 o0, o1;
#pragma unroll
                for (int r = 0; r < 16; ++r) { o0[r] = 0.f; o1[r] = 0.f; }
                attn_core<0, 5>(qh_ + (size_t)n0 * 64, 64, kh_, vh_, 64, 0, 1, n0 - 128, nq, 127, m, l, o0, o1, vl, lane);
                l = xhalf_sum(l);
                attn_finalize(o0, o1, l, gh_ + (size_t)n0 * 64, Y + ((size_t)b * SEQ + n0) * DM + qh * 64, vl, lane);
            }
        }
    }
}

__device__ __forceinline__ void phase_post(const Params& p) {
    const int tid = threadIdx.x, lane = tid & 63, wid = tid >> 6, gw = blockIdx.x * 8 + wid, nw = gridDim.x * 8;
    const float* Z = (const float*)(p.ws + OFF_Z);
    for (int row = gw; row < NTOK; row += 2 * nw) {
        const int row2 = row + nw < NTOK ? row + nw : row;
        f32x4 v[4], w2[4], xa[4], xb2[4];
#pragma unroll
        for (int i = 0; i < 4; ++i) { v[i] = *(const f32x4*)(Z + (size_t)row * DM + i * 256 + lane * 4); w2[i] = *(const f32x4*)(Z + (size_t)row2 * DM + i * 256 + lane * 4);
                                      xa[i] = *(const f32x4*)(p.x + (size_t)row * DM + i * 256 + lane * 4); xb2[i] = *(const f32x4*)(p.x + (size_t)row2 * DM + i * 256 + lane * 4); }
        float ss = 0.f, ss2 = 0.f;
#pragma unroll
        for (int i = 0; i < 4; ++i) { ss += v[i][0] * v[i][0] + v[i][1] * v[i][1] + v[i][2] * v[i][2] + v[i][3] * v[i][3];
                                      ss2 += w2[i][0] * w2[i][0] + w2[i][1] * w2[i][1] + w2[i][2] * w2[i][2] + w2[i][3] * w2[i][3]; }
        ss = wave_sum(ss); ss2 = wave_sum(ss2);
        const float r = rsqrtf(ss * (1.0f / 1024.0f) + 1e-6f), r2 = rsqrtf(ss2 * (1.0f / 1024.0f) + 1e-6f);
#pragma unroll
        for (int i = 0; i < 4; ++i) {
            const f32x4 gg = *(const f32x4*)(p.post_g + i * 256 + lane * 4);
            *(f32x4*)(p.out + (size_t)row * DM + i * 256 + lane * 4) = xa[i] + v[i] * r * gg;
            *(f32x4*)(p.out + (size_t)row2 * DM + i * 256 + lane * 4) = xb2[i] + w2[i] * r2 * gg;
        }
    }
}


#define XB_TMO      128
#define XB_XCNT(j)  (256  + 64 * (j))
#define XB_XSUB(j)  (1280 + 64 * (j))
#define XB_XGEN(j)  (2304 + 64 * (j))
#define XB_TOP      3328
#define XB_TOPGEN   3392
#define XCD_BAR_WORDS 3456
#define XB_SPIN_CAP (1u << 18)

__device__ __forceinline__ unsigned xb_ld(unsigned* p)              { return __hip_atomic_load(p, __ATOMIC_RELAXED, __HIP_MEMORY_SCOPE_AGENT); }
__device__ __forceinline__ unsigned xb_add(unsigned* p, unsigned v) { return __hip_atomic_fetch_add(p, v, __ATOMIC_RELAXED, __HIP_MEMORY_SCOPE_AGENT); }
__device__ __forceinline__ unsigned xb_xcc_id() { return (unsigned)__builtin_amdgcn_s_getreg((3 << 11) | 20) & 0xFu; }
#define XB_SPIN(cond, bar) do { unsigned _sp = 0; while (cond) { __builtin_amdgcn_s_sleep(1); \
    if ((++_sp & 255u) == 0u) { if (xb_ld(&(bar)[XB_TMO])) break; if (_sp > XB_SPIN_CAP) { atomicAdd(&(bar)[XB_TMO], 1u); break; } } } } while (0)

struct XcdBarrier {
    unsigned* bar; unsigned x;
    volatile LAS unsigned* st;
};

__device__ __forceinline__ XcdBarrier xcd_barrier_post(unsigned* bar, volatile LAS unsigned* st) {
    XcdBarrier b; b.bar = bar; b.x = xb_xcc_id(); b.st = st;
    if (threadIdx.x == 0) (void)xb_add(&bar[XB_XCNT(b.x)], 1u);
    return b;
}
__device__ __forceinline__ void xcd_barrier_complete(unsigned* bar, unsigned x, unsigned& nloc, unsigned& nx) {
    const unsigned G = gridDim.x * gridDim.y * gridDim.z;
    unsigned sum, cnt, mine, sp = 0u;
    for (;;) {
        sum = 0u; cnt = 0u; mine = 0u;
#pragma unroll
        for (unsigned j = 0; j < 16; ++j) { const unsigned c = xb_ld(&bar[XB_XCNT(j)]); sum += c; cnt += (c > 0u) ? 1u : 0u; mine = (j == x) ? c : mine; }
        if (sum == G) break;
        __builtin_amdgcn_s_sleep(1);
        if ((++sp & 255u) == 0u) { if (xb_ld(&bar[XB_TMO])) break; if (sp > XB_SPIN_CAP) { atomicAdd(&bar[XB_TMO], 1u); break; } }
    }
    nloc = mine > 0u ? mine : 1u; nx = cnt > 0u ? cnt : 1u;
}

__device__ __forceinline__ void xcd_barrier(const XcdBarrier& b) {
    asm volatile("s_waitcnt vmcnt(0)" ::: "memory");
    __syncthreads();
    if (threadIdx.x == 0) {
        unsigned* bar = b.bar;
        __builtin_amdgcn_s_waitcnt(0);
        unsigned nloc = b.st[0], nx = b.st[1];
        if (nloc == 0u) { xcd_barrier_complete(bar, b.x, nloc, nx); b.st[0] = nloc; b.st[1] = nx; }
        const unsigned old = xb_add(&bar[XB_XSUB(b.x)], 1u);
        const unsigned gen = old / nloc;
        if (old + 1u == (gen + 1u) * nloc) {
            __builtin_amdgcn_fence(__ATOMIC_RELEASE, "agent");
            asm volatile("s_waitcnt vmcnt(0)" ::: "memory");
            const unsigned og = xb_add(&bar[XB_TOP], 1u);
            const unsigned tg = og / nx;
            if (og + 1u == (tg + 1u) * nx) xb_add(&bar[XB_TOPGEN], 1u);
            else XB_SPIN(xb_ld(&bar[XB_TOPGEN]) == tg, bar);
            __builtin_amdgcn_fence(__ATOMIC_ACQUIRE, "agent");
            xb_add(&bar[XB_XGEN(b.x)], 1u);
            asm volatile("s_waitcnt vmcnt(0)" ::: "memory");
        } else {
            XB_SPIN(xb_ld(&bar[XB_XGEN(b.x)]) == gen, bar);
            __builtin_amdgcn_fence(__ATOMIC_ACQUIRE, "agent");
            asm volatile("s_waitcnt vmcnt(0)" ::: "memory");
        }
    }
    __syncthreads();
}

__global__ __launch_bounds__(512, 2) void fwd_kernel(Params p) {
    extern __shared__ __attribute__((aligned(16))) unsigned char smem[];
    cg::grid_group grid = cg::this_grid();
    LAS unsigned char* lds = (LAS unsigned char*)smem;
    if (threadIdx.x < 4) ((LAS unsigned*)(lds + ST_XB))[threadIdx.x] = 0u;
    __syncthreads();
    const XcdBarrier xb = xcd_barrier_post((unsigned*)(p.ws + OFF_BAR), (volatile LAS unsigned*)(lds + ST_XB));
    if (p.out == nullptr) grid.sync();
#define GSYNC() xcd_barrier(xb)
#define GIN_BLOCK { \
        pg8::Gemm g; g.A = (const bf16_t*)(p.ws + OFF_U); g.Bt = (const bf16_t*)(p.ws + OFF_WINT); g.M = NTOK; g.N = DIN; g.K = DM; \
        pg8::StaticOrder S; S.init(NTOK, DIN, (int)gridDim.x, (int)blockIdx.x); \
        EpiIn E; E.proj = (bf16_t*)(p.ws + OFF_PROJ); E.mkv = (bf16_t*)(p.ws + OFF_MKV); E.rope = (const float*)(p.ws + OFF_ROPE); \
        pg8::gemm_phase<EpiIn, pg8::StaticOrder, false>(lds, g, S, E, nullptr); \
        GSYNC(); }
#define GOUT_BLOCK { \
        pg8::Gemm g; g.A = (const bf16_t*)(p.ws + OFF_Y); g.Bt = (const bf16_t*)(p.ws + OFF_WOUTT); g.M = NTOK; g.N = DM; g.K = DM; \
        OneUnit S; S.so.init(NTOK, DM, (int)gridDim.x, (int)blockIdx.x); \
        EpiOutFused E; E.x = p.x; E.g = p.post_g; E.out = p.out; E.part = (float*)(p.ws + OFF_PART); E.cnt = (unsigned*)(p.ws + OFF_CNT); \
        S.round = 0; pg8::gemm_phase<EpiOutFused, OneUnit, false>(lds, g, S, E, nullptr); \
        S.round = 1; pg8::gemm_phase<EpiOutFused, OneUnit, false>(lds, g, S, E, nullptr); }
    phase_prep(p); GSYNC();
#ifdef REP_SYNC
    GSYNC(); GSYNC(); GSYNC(); GSYNC(); GSYNC(); GSYNC(); GSYNC(); GSYNC();
#endif
#ifdef REP_PREP
    phase_prep(p); GSYNC();
#endif
    GIN_BLOCK
#if REP_GIN > 1
    GIN_BLOCK
#endif
    phase_attn(p, lds, 0, 0, 1024, xb.x); GSYNC();
#if REP_ATTN > 1
    phase_attn(p, lds, 1, REP_LO, REP_HI, xb.x); GSYNC();
#endif
    GOUT_BLOCK
#ifdef REP_GOUT
    if (gridDim.x == 256u) GOUT_BLOCK
    else {
        pg8::Gemm g; g.A = (const bf16_t*)(p.ws + OFF_Y); g.Bt = (const bf16_t*)(p.ws + OFF_WOUTT); g.M = NTOK; g.N = DM; g.K = DM;
        pg8::StaticOrder S; S.init(NTOK, DM, (int)gridDim.x, (int)blockIdx.x);
        pg8::EpiF32 E; E.C = (float*)(p.ws + OFF_Z); E.ldc = DM; E.bias = nullptr;
        pg8::gemm_phase<pg8::EpiF32, pg8::StaticOrder, false>(lds, g, S, E, nullptr);
        GSYNC();
        phase_post(p);
    }
#endif
}

extern "C" void kernel_launch(void* const* d_in, const int* in_sizes, int n_in, void* d_out, int out_size, void* d_ws, size_t ws_size, hipStream_t stream) {
    static int grid_blocks = 0;
    if (!grid_blocks) {
        int dev = 0, cus = 0, per_cu = 0;
        hipGetDevice(&dev);
        hipDeviceGetAttribute(&cus, hipDeviceAttributeMultiprocessorCount, dev);
        hipFuncSetAttribute((const void*)fwd_kernel, hipFuncAttributeMaxDynamicSharedMemorySize, LDS_BYTES);
        hipOccupancyMaxActiveBlocksPerMultiprocessor(&per_cu, (const void*)fwd_kernel, 512, LDS_BYTES);
        if (per_cu < 1) { fprintf(stderr, "occupancy query returned %d\n", per_cu); per_cu = 1; }
        grid_blocks = cus * per_cu;
    }
    Params p{};
    p.x = (const float*)d_in[0]; p.mem = (const float*)d_in[1]; p.pre_g = (const float*)d_in[2]; p.w_in = (const float*)d_in[3]; p.sink = (const float*)d_in[4];
    p.mem_g = (const float*)d_in[5]; p.w_memkv = (const float*)d_in[6]; p.w_out = (const float*)d_in[7]; p.post_g = (const float*)d_in[8];
    p.out = (float*)d_out; p.ws = (unsigned char*)d_ws;
    void* args[] = {&p};
    hipMemsetAsync((unsigned char*)d_ws + OFF_BAR, 0, 16384 + 8192, stream);
    hipError_t e = hipLaunchCooperativeKernel((const void*)fwd_kernel, dim3(grid_blocks), dim3(512), args, LDS_BYTES, stream);
    if (e != hipSuccess) fprintf(stderr, "cooperative launch failed: %s (grid %d)\n", hipGetErrorString(e), grid_blocks);
}
```

```cpp
#include <hip/hip_runtime.h>
#include <hip/hip_cooperative_groups.h>
#include <cstdio>
namespace cg = cooperative_groups;
namespace pg8 {
#define PG8_LAS __attribute__((address_space(3)))
typedef unsigned short bf16_t;
typedef short bf16x8 __attribute__((ext_vector_type(8)));
typedef float f32x4 __attribute__((ext_vector_type(4)));
typedef unsigned u32x4 __attribute__((ext_vector_type(4)));
constexpr int BM = 256, BK = 64, HALF = 128, HTB = HALF * BK * 2  , STAGE_BYTES = 8 * HTB, NXCD = 8, WGM = 8;

__host__ __device__ __forceinline__ int lds_byte(int r, int c) { const int st = (r >> 4) * 2 + (c >> 5), rr = r & 15, cc = c & 31, ob = rr * 64 + cc * 2; return st * 1024 + (ob ^ (((ob >> 9) & 1) << 5)); }
__host__ __device__ __forceinline__ void stage_rc(int b, int& R, int& C) { const int st = b / 1024, sb = b % 1024, swz = sb ^ (((sb >> 9) & 1) << 5); R = (st >> 1) * 16 + swz / 64; C = (st & 1) * 32 + (swz % 64) / 2; }
__host__ __device__ __forceinline__ int perm32(int rho) { const int n = rho >> 4, i = rho & 15; return 8 * (i >> 2) + 4 * n + (i & 3); }

struct Unit { int pm, pn; };
struct Gemm { const bf16_t* A; const bf16_t* Bt; int M, N, K; };
struct StaticOrder {
    int nM, nN, nwg, G, c;
    __host__ __device__ void init(int M, int N, int G_, int c_) { nM = M / BM; nN = N / BM; nwg = nM * nN; G = G_; c = c_; }
    __host__ __device__ bool next(int i, Unit& u) const {
        const long L = (long)i * G + c; if (L >= nwg) return false;
        int wgid = (int)L; { const int q = nwg / NXCD, r = nwg % NXCD, xcd = wgid % NXCD, off = wgid / NXCD; wgid = (xcd < r ? xcd * (q + 1) : r * (q + 1) + (xcd - r) * q) + off; }
        const int nig = WGM * nN, gid = wgid / nig, fm = gid * WGM, gsz = (nM - fm) < WGM ? (nM - fm) : WGM;
        u.pm = fm + ((wgid % nig) % gsz); u.pn = (wgid % nig) / gsz; return true;
    }
    __device__ __forceinline__ void a_ready(const Unit&) const {}
    __device__ __forceinline__ void done(const Unit&) const {}
};
__device__ __forceinline__ unsigned cvt_pk_bf16(float lo, float hi) { unsigned r; asm volatile("v_cvt_pk_bf16_f32 %0, %1, %2" : "=v"(r) : "v"(lo), "v"(hi)); return r; }
struct EpiF32 {
    static constexpr bool PERM = false, AFTER_DRAIN = false;
    float* C; int ldc; const float* bias;
    __device__ __forceinline__ void operator()(const f32x4 (&acc)[2][2][4][2], const Unit& u, int wr, int wc, int fr, int fq) const {
        const int row0 = u.pm * BM + wr * 64 + fr, col0 = u.pn * BM + wc * 32 + 4 * fq;
        f32x4 bv[2][2];
#pragma unroll
        for (int bj = 0; bj < 2; ++bj)
#pragma unroll
            for (int n = 0; n < 2; ++n) bv[bj][n] = bias ? *(const f32x4*)(bias + col0 + bj * HALF + n * 16) : (f32x4){0.f, 0.f, 0.f, 0.f};
#pragma unroll
        for (int ai = 0; ai < 2; ++ai)
#pragma unroll
            for (int m = 0; m < 4; ++m) { float* rowp = C + (size_t)(row0 + ai * HALF + m * 16) * ldc + col0;
#pragma unroll
                for (int bj = 0; bj < 2; ++bj)
#pragma unroll
                    for (int n = 0; n < 2; ++n) *(f32x4*)(rowp + bj * HALF + n * 16) = acc[ai][bj][m][n] + bv[bj][n]; }
    }
};
template <class Epi, class Sched, bool STAMP = false>
__device__ __forceinline__ void gemm_phase(PG8_LAS unsigned char* lds, const Gemm g, const Sched& S, const Epi& E, unsigned long long* stamps) {
    const int tid = threadIdx.x, wid = __builtin_amdgcn_readfirstlane(tid >> 6), lane = tid & 63, wr = wid >> 2, wc = wid & 3, fr = lane & 15, fq = lane >> 4;
    const int K = g.K, nt = K / BK;
#define PG8_STAMP() do {} while (0)
    unsigned voffA[2], voffB[2];
#pragma unroll
    for (int i = 0; i < 2; ++i) { int R, C; stage_rc(tid * 16 + i * 8192, R, C); const int Rb = Epi::PERM ? ((R & ~31) + perm32(R & 31)) : R;
        voffA[i] = (unsigned)(R * K + C) * 2u; voffB[i] = (unsigned)(Rb * K + C) * 2u; }
    const size_t kstep = (size_t)(BK * 2);
    const size_t hstep = (size_t)HALF * K * 2;
    const size_t tstep = 2 * hstep;
    const unsigned ldsw = (unsigned)wid * 1024u;
    const int aoff = lds_byte(wr * 64 + fr, fq * 8), boff = lds_byte(wc * 32 + fr, fq * 8);
#define PG8_SA(b, h) (((b) * 2 + (h)) * HTB)
#define PG8_SB(b, h) ((4 + (b) * 2 + (h)) * HTB)
#define PG8_STAGE(bufoff, gbase, voff) do { _Pragma("unroll") for (int _i = 0; _i < 2; ++_i) \
        __builtin_amdgcn_global_load_lds((const unsigned*)((const char*)(gbase) + (voff)[_i]), (PG8_LAS unsigned*)(lds + (bufoff) + ldsw + _i * 8192), 16, 0, 0); } while (0)
#define PG8_LDA(dst, b, h) do { _Pragma("unroll") for (int m = 0; m < 4; ++m) _Pragma("unroll") for (int k = 0; k < 2; ++k) dst[m][k] = *(const PG8_LAS bf16x8*)(lds + PG8_SA(b, h) + aoff + m * 2048 + k * 1024); } while (0)
#define PG8_LDB(dst, b, h) do { _Pragma("unroll") for (int n = 0; n < 2; ++n) _Pragma("unroll") for (int k = 0; k < 2; ++k) dst[n][k] = *(const PG8_LAS bf16x8*)(lds + PG8_SB(b, h) + boff + n * 2048 + k * 1024); } while (0)
#define PG8_MMA(ai, bj, At, Bt) do { __builtin_amdgcn_s_setprio(1); _Pragma("unroll") for (int m = 0; m < 4; ++m) _Pragma("unroll") for (int n = 0; n < 2; ++n) _Pragma("unroll") for (int k = 0; k < 2; ++k) \
        acc[ai][bj][m][n] = __builtin_amdgcn_mfma_f32_16x16x32_bf16(Bt[n][k], At[m][k], acc[ai][bj][m][n], 0, 0, 0); __builtin_amdgcn_s_setprio(0); } while (0)
#define PG8_WAIT_V(n) asm volatile("s_waitcnt vmcnt(" #n ")" ::: "memory")
#define PG8_WAIT_L(n) asm volatile("s_waitcnt lgkmcnt(" #n ")" ::: "memory")
#define PG8_BAR __builtin_amdgcn_s_barrier()
#define PG8_SCHED __builtin_amdgcn_sched_barrier(0)
    Unit cur, nxt; int ui = 0;
    if (!S.next(0, cur)) return;
    f32x4 acc[2][2][4][2];
#pragma unroll
    for (int a = 0; a < 2; ++a)
#pragma unroll
        for (int b = 0; b < 2; ++b)
#pragma unroll
            for (int m = 0; m < 4; ++m)
#pragma unroll
                for (int n = 0; n < 2; ++n) acc[a][b][m][n] = (f32x4){0.f, 0.f, 0.f, 0.f};
    bf16x8 At[4][2], B0[2][2], B1[2][2];
    const char* cA = (const char*)g.A + (size_t)cur.pm * tstep; const char* cB = (const char*)g.Bt + (size_t)cur.pn * tstep;
    S.a_ready(cur);
    PG8_STAGE(PG8_SB(0, 0), cB, voffB); PG8_STAGE(PG8_SA(0, 0), cA, voffA); PG8_STAGE(PG8_SB(0, 1), cB + hstep, voffB); PG8_STAGE(PG8_SA(0, 1), cA + hstep, voffA);
    if (wr == 1) PG8_BAR;
    PG8_WAIT_V(4); PG8_BAR;
    PG8_STAGE(PG8_SB(1, 0), cB + kstep, voffB); PG8_STAGE(PG8_SA(1, 0), cA + kstep, voffA); PG8_STAGE(PG8_SB(1, 1), cB + hstep + kstep, voffB);
    PG8_WAIT_V(6); PG8_BAR;
    PG8_STAMP();
    for (;;) {
        const bool has_next = S.next(ui + 1, nxt);
        const char* nA = has_next ? (const char*)g.A + (size_t)nxt.pm * tstep : cA; const char* nB = has_next ? (const char*)g.Bt + (size_t)nxt.pn * tstep : cB;
        for (int t = 0; t < nt; t += 2) {
            const bool last = (t == nt - 2);
            const char* a1 = cA + (size_t)(t + 1) * kstep;
            const char* a2 = last ? nA : cA + (size_t)(t + 2) * kstep; const char* b2 = last ? nB : cB + (size_t)(t + 2) * kstep;
            const char* a3 = a2 + kstep; const char* b3 = b2 + kstep;
            if (last && has_next) S.a_ready(nxt);
            PG8_LDB(B0, 0, 0); PG8_SCHED; PG8_LDA(At, 0, 0); PG8_STAGE(PG8_SA(1, 1), a1 + hstep, voffA);
            PG8_WAIT_L(8); PG8_BAR; PG8_WAIT_L(0); PG8_MMA(0, 0, At, B0); PG8_BAR; PG8_SCHED;
            PG8_LDB(B1, 0, 1); PG8_STAGE(PG8_SB(0, 0), b2, voffB);
            PG8_BAR; PG8_WAIT_L(0); PG8_MMA(0, 1, At, B1); PG8_BAR;
            PG8_LDA(At, 0, 1); PG8_STAGE(PG8_SA(0, 0), a2, voffA);
            PG8_BAR; PG8_WAIT_L(0); PG8_MMA(1, 0, At, B0); PG8_BAR; PG8_SCHED;
            PG8_STAGE(PG8_SB(0, 1), b2 + hstep, voffB);
            PG8_WAIT_V(6); PG8_BAR; PG8_MMA(1, 1, At, B1); PG8_BAR;
            PG8_LDB(B0, 1, 0); PG8_SCHED; PG8_LDA(At, 1, 0); PG8_STAGE(PG8_SA(0, 1), a2 + hstep, voffA);
            PG8_WAIT_L(8); PG8_BAR; PG8_WAIT_L(0); PG8_MMA(0, 0, At, B0); PG8_BAR; PG8_SCHED;
            PG8_LDB(B1, 1, 1); PG8_STAGE(PG8_SB(1, 0), b3, voffB);
            PG8_BAR; PG8_WAIT_L(0); PG8_MMA(0, 1, At, B1); PG8_BAR;
            PG8_LDA(At, 1, 1); PG8_STAGE(PG8_SA(1, 0), a3, voffA);
            PG8_BAR; PG8_WAIT_L(0); PG8_MMA(1, 0, At, B0); PG8_BAR; PG8_SCHED;
            PG8_STAGE(PG8_SB(1, 1), b3 + hstep, voffB);
            PG8_WAIT_V(6); PG8_BAR; PG8_MMA(1, 1, At, B1); PG8_BAR;
        }
        PG8_STAMP();
        if constexpr (!Epi::AFTER_DRAIN) { E(acc, cur, wr, wc, fr, fq); S.done(cur); }
        PG8_STAMP();
        if (!has_next) break;
#pragma unroll
        for (int a = 0; a < 2; ++a)
#pragma unroll
            for (int b = 0; b < 2; ++b)
#pragma unroll
                for (int m = 0; m < 4; ++m)
#pragma unroll
                    for (int n = 0; n < 2; ++n) acc[a][b][m][n] = (f32x4){0.f, 0.f, 0.f, 0.f};
        cur = nxt; cA = nA; cB = nB; ++ui;
    }
    PG8_WAIT_V(0);
    if (wr == 0) PG8_BAR;
    PG8_BAR;
    if constexpr (Epi::AFTER_DRAIN) { E.fused(acc, cur, wr, wc, fr, fq, lds, wid, lane); S.done(cur); }
    PG8_STAMP();
#undef PG8_STAMP
#undef PG8_SA
#undef PG8_SB
#undef PG8_STAGE
#undef PG8_LDA
#undef PG8_LDB
#undef PG8_MMA
#undef PG8_WAIT_V
#undef PG8_WAIT_L
#undef PG8_BAR
#undef PG8_SCHED
}
}
using pg8::bf16_t; using pg8::bf16x8; using pg8::f32x4; using pg8::u32x4; using pg8::Unit;
#define LAS __attribute__((address_space(3)))
typedef short s16x4 __attribute__((ext_vector_type(4)));
typedef float f32x16 __attribute__((ext_vector_type(16)));
typedef float f32x2 __attribute__((ext_vector_type(2)));
typedef __bf16 bf16x2_t __attribute__((ext_vector_type(2)));
typedef unsigned u32x2 __attribute__((ext_vector_type(2)));

constexpr int NTOK = 32768, SEQ = 8192, DM = 1024, DIN = 3072, MROWS = 32768 + 1024;
constexpr size_t OFF_U = 0, OFF_WINT = 69206016, OFF_WOUTT = 76546048, OFF_ROPE = 78643200, OFF_MKV = 79167488, OFF_CTR = 80216064,
                 OFF_Y = OFF_U  , OFF_PROJ = 147325184, OFF_Z = OFF_PROJ, OFF_BAR = 348651776, OFF_CNT = OFF_BAR + 16384, OFF_QCTR = OFF_CNT + 1024, OFF_PART = OFF_CNT + 8192;
#ifndef REP_ATTN
#define REP_ATTN 1
#endif
#ifndef REP_GIN
#define REP_GIN 1
#endif
#ifndef REP_MISC
#define REP_MISC 1
#endif
constexpr int LDS_BYTES = 159776;
constexpr int ST_ROWB = 136, ST_ML = 69632, ST_V = 73728, ST_VW = 10752, ST_K = 6144, ST_ITEM = 159744, ST_XB = 159760, VROWB = 192, KROWB = 144;

struct Params { const float *x, *mem, *pre_g, *w_in, *sink, *mem_g, *w_memkv, *w_out, *post_g; float* out; unsigned char* ws; };

__device__ __forceinline__ unsigned pack2(float lo, float hi) { f32x2 v; v.x = lo; v.y = hi; return __builtin_bit_cast(unsigned, __builtin_convertvector(v, bf16x2_t)); }
__device__ __forceinline__ float bflo(unsigned w) { return __uint_as_float(w << 16); }
__device__ __forceinline__ float bfhi(unsigned w) { return __uint_as_float(w & 0xffff0000u); }
__device__ __forceinline__ float wave_sum(float v) {
#pragma unroll
    for (int o = 32; o >= 1; o >>= 1) v += __shfl_xor(v, o);
    return v;
}

__device__ __forceinline__ void transpose_tile(const float* __restrict__ W, int N, bf16_t* __restrict__ WT, int task, int lane) {
    const int ntn = N >> 6, k0 = (task / ntn) * 64, n = (task % ntn) * 64 + lane;
    const float* src = W + (size_t)k0 * N + n;
    float v[64];
#pragma unroll
    for (int r = 0; r < 64; ++r) v[r] = __builtin_nontemporal_load(src + (size_t)r * N);
    bf16_t* dst = WT + (size_t)n * 1024 + k0;
#pragma unroll
    for (int q = 0; q < 8; ++q) {
        u32x4 w; w.x = pack2(v[8 * q], v[8 * q + 1]); w.y = pack2(v[8 * q + 2], v[8 * q + 3]); w.z = pack2(v[8 * q + 4], v[8 * q + 5]); w.w = pack2(v[8 * q + 6], v[8 * q + 7]);
        *(u32x4*)(dst + 8 * q) = w;
    }
}
__device__ __forceinline__ void phase_prep(const Params& p) {
    const int tid = threadIdx.x, lane = tid & 63, wid = tid >> 6;
    const int gw = blockIdx.x * 8 + wid, nw = gridDim.x * 8, gt = blockIdx.x * 512 + tid, nt = gridDim.x * 512;
    bf16_t* U = (bf16_t*)(p.ws + OFF_U);
    if (blockIdx.x == 0 && tid < 2) ((unsigned*)(p.ws + OFF_CTR))[tid * 8] = 0u;
    for (int row = gw; row < MROWS; row += 2 * nw) {
        const int row2 = row + nw < MROWS ? row + nw : row;
        const float* src = row < NTOK ? p.x + (size_t)row * DM : p.mem + (size_t)(row - NTOK) * DM;
        const float* src2 = row2 < NTOK ? p.x + (size_t)row2 * DM : p.mem + (size_t)(row2 - NTOK) * DM;
        const float* g = row < NTOK ? p.pre_g : p.mem_g;
        const float* g2 = row2 < NTOK ? p.pre_g : p.mem_g;
        f32x4 v[4], w2[4];
#pragma unroll
        for (int i = 0; i < 4; ++i) { v[i] = __builtin_nontemporal_load((const f32x4*)(src + i * 256 + lane * 4)); w2[i] = __builtin_nontemporal_load((const f32x4*)(src2 + i * 256 + lane * 4)); }
        float ss = 0.f, ss2 = 0.f;
#pragma unroll
        for (int i = 0; i < 4; ++i) { ss += v[i][0] * v[i][0] + v[i][1] * v[i][1] + v[i][2] * v[i][2] + v[i][3] * v[i][3];
                                      ss2 += w2[i][0] * w2[i][0] + w2[i][1] * w2[i][1] + w2[i][2] * w2[i][2] + w2[i][3] * w2[i][3]; }
        ss = wave_sum(ss); ss2 = wave_sum(ss2);
        const float r = rsqrtf(ss * (1.0f / 1024.0f) + 1e-6f), r2 = rsqrtf(ss2 * (1.0f / 1024.0f) + 1e-6f);
#pragma unroll
        for (int i = 0; i < 4; ++i) {
            const f32x4 gg = *(const f32x4*)(g + i * 256 + lane * 4), gg2 = *(const f32x4*)(g2 + i * 256 + lane * 4);
            u32x2 w; w.x = pack2(v[i][0] * r * gg[0], v[i][1] * r * gg[1]); w.y = pack2(v[i][2] * r * gg[2], v[i][3] * r * gg[3]);
            *(u32x2*)(U + (size_t)row * DM + i * 256 + lane * 4) = w;
            u32x2 y; y.x = pack2(w2[i][0] * r2 * gg2[0], w2[i][1] * r2 * gg2[1]); y.y = pack2(w2[i][2] * r2 * gg2[2], w2[i][3] * r2 * gg2[3]);
            *(u32x2*)(U + (size_t)row2 * DM + i * 256 + lane * 4) = y;
        }
    }
    bf16_t* WinT = (bf16_t*)(p.ws + OFF_WINT);
    for (int task = gw; task < 768 + 128 + 256; task += nw) {
        if (task < 768) transpose_tile(p.w_in, 3072, WinT, task, lane);
        else if (task < 896) transpose_tile(p.w_memkv, 512, WinT + (size_t)3072 * 1024, task - 768, lane);
        else transpose_tile(p.w_out, 1024, (bf16_t*)(p.ws + OFF_WOUTT), task - 896, lane);
    }
    float* rope = (float*)(p.ws + OFF_ROPE);
    for (int it = gt; it < SEQ * 8; it += nt) {
        const int pos = it >> 3, i = it & 7;
        const float inv = i == 0 ? 1.0f : i == 1 ? 0x1.8d275ep-3f : i == 2 ? 0x1.341190p-5f : i == 3 ? 0x1.ddee9cp-8f : i == 4 ? 0x1.72ba44p-10f : i == 5 ? 0x1.1f91f0p-12f : i == 6 ? 0x1.be2188p-15f : 0x1.5a0f4ep-17f;
        const float ang = (float)pos * inv;
        rope[pos * 16 + i] = cosf(ang); rope[pos * 16 + 8 + i] = sinf(ang);
    }
}

struct MemUnit {
    int L;
    __device__ bool next(int i, Unit& u) const { if (i != 0) return false; u.pm = 128 + (L >> 1); u.pn = 12 + (L & 1); return true; }
    __device__ __forceinline__ void a_ready(const Unit&) const {}
    __device__ __forceinline__ void done(const Unit&) const {}
};
struct EpiIn {
    static constexpr bool PERM = true, AFTER_DRAIN = false;
    bf16_t* proj; bf16_t* mkv; const float* rope;
    __device__ __forceinline__ void operator()(const f32x4 (&acc)[2][2][4][2], const Unit& u, int wr, int wc, int fr, int fq) const {
        if (u.pm >= 128) {
            const int row0 = (u.pm - 128) * 256 + wr * 64 + fr, col0 = (u.pn - 12) * 256 + wc * 32 + 8 * fq;
#pragma unroll
            for (int ai = 0; ai < 2; ++ai)
#pragma unroll
                for (int m = 0; m < 4; ++m) { bf16_t* rowp = mkv + (size_t)(row0 + ai * 128 + m * 16) * 512 + col0;
#pragma unroll
                    for (int bj = 0; bj < 2; ++bj) { const f32x4 v0 = acc[ai][bj][m][0], v1 = acc[ai][bj][m][1];
                        u32x4 w; w.x = pack2(v0[0], v0[1]); w.y = pack2(v0[2], v0[3]); w.z = pack2(v1[0], v1[1]); w.w = pack2(v1[2], v1[3]);
                        *(u32x4*)(rowp + bj * 128) = w; } }
            return;
        }
        const int row0 = u.pm * 256 + wr * 64 + fr;
        bf16_t* __restrict__ projr = proj; const float* __restrict__ roper = rope;
#pragma unroll
        for (int bj = 0; bj < 2; ++bj) {
            const int cg0 = u.pn * 256 + bj * 128 + wc * 32;
            const float scale = (cg0 < 384 || (cg0 >= 1024 && cg0 < 1408) || (cg0 >= 2560 && cg0 < 2816)) ? 0.18033688011112042f : 1.0f;
            const bool rope_on = (cg0 < 512 || (cg0 >= 1024 && cg0 < 1792)) && ((cg0 & 63) == 0);
            const bool gate_cols = (cg0 >= 640 && cg0 < 1024) || (cg0 >= 2176 && cg0 < 2560) || cg0 >= 2816;
#pragma unroll
            for (int ai = 0; ai < 2; ++ai)
#pragma unroll
                for (int m = 0; m < 4; ++m) {
                    const int row = row0 + ai * 128 + m * 16;
                    f32x4 v0 = acc[ai][bj][m][0], v1 = acc[ai][bj][m][1];
                    if (rope_on) {
                        f32x4 p0, p1;
#pragma unroll
                        for (int j = 0; j < 4; ++j) { p0[j] = __shfl_xor(v0[j], 16); p1[j] = __shfl_xor(v1[j], 16); }
                        if (fq < 2) {
                            const float* cs = roper + (size_t)(row & (SEQ - 1)) * 16;
                            const f32x4 c0 = *(const f32x4*)(cs), c1 = *(const f32x4*)(cs + 4), s0 = *(const f32x4*)(cs + 8), s1 = *(const f32x4*)(cs + 12);
                            const float sg = fq == 0 ? -1.0f : 1.0f;
                            v0 = v0 * c0 + sg * (p0 * s0); v1 = v1 * c1 + sg * (p1 * s1);
                        }
                    }
                    v0 *= scale; v1 *= scale;
                    if (gate_cols) {
#pragma unroll
                        for (int j = 0; j < 4; ++j) { v0[j] = v0[j] * __builtin_amdgcn_rcpf(1.0f + __expf(-v0[j])); v1[j] = v1[j] * __builtin_amdgcn_rcpf(1.0f + __expf(-v1[j])); }
                    }
                    u32x4 w; w.x = pack2(v0[0], v0[1]); w.y = pack2(v0[2], v0[3]); w.z = pack2(v1[0], v1[1]); w.w = pack2(v1[2], v1[3]);
                    *(u32x4*)(projr + ((size_t)(cg0 >> 6) * NTOK + row) * 64 + (cg0 & 63) + 8 * fq) = w;
                }
        }
    }
};

struct OneUnit {
    pg8::StaticOrder so; int round;
    __device__ bool next(int i, Unit& u) const { return i == 0 ? so.next(round, u) : false; }
    __device__ __forceinline__ void a_ready(const Unit&) const {}
    __device__ __forceinline__ void done(const Unit&) const {}
};
struct EpiOutFused {
    static constexpr bool PERM = false, AFTER_DRAIN = true;
    const float* x; const float* g; float* out; float* part; unsigned* cnt;
    __device__ __forceinline__ void fused(const f32x4 (&acc)[2][2][4][2], const Unit& u, int wr, int wc, int fr, int fq, LAS unsigned char*, int, int) const {
        const int row0 = u.pm * 256 + wr * 64 + fr, col0 = u.pn * 256 + wc * 32 + 4 * fq;
#pragma unroll
        for (int ai = 0; ai < 2; ++ai)
#pragma unroll
            for (int m = 0; m < 4; ++m) {
                float ss = 0.f;
#pragma unroll
                for (int bj = 0; bj < 2; ++bj)
#pragma unroll
                    for (int n = 0; n < 2; ++n) { const f32x4 v = acc[ai][bj][m][n]; ss += v[0] * v[0] + v[1] * v[1] + v[2] * v[2] + v[3] * v[3]; }
                ss += __shfl_xor(ss, 16); ss += __shfl_xor(ss, 32);
                if (fq == 0) __hip_atomic_store(part + (size_t)(row0 + ai * 128 + m * 16) * 16 + u.pn * 4 + wc, ss, __ATOMIC_RELAXED, __HIP_MEMORY_SCOPE_AGENT);
            }
        asm volatile("s_waitcnt vmcnt(0)" ::: "memory");
        __syncthreads();
        if (threadIdx.x == 0) {
            __hip_atomic_fetch_add(cnt + u.pm, 1u, __ATOMIC_RELAXED, __HIP_MEMORY_SCOPE_AGENT);
            unsigned sp = 0; while (__hip_atomic_load(cnt + u.pm, __ATOMIC_RELAXED, __HIP_MEMORY_SCOPE_AGENT) < 4u && ++sp < (1u << 22)) __builtin_amdgcn_s_sleep(2);
        }
        f32x4 gv[2][2];
#pragma unroll
        for (int bj = 0; bj < 2; ++bj)
#pragma unroll
            for (int n = 0; n < 2; ++n) gv[bj][n] = *(const f32x4*)(g + col0 + bj * 128 + n * 16);
        __syncthreads();
        asm volatile("" ::: "memory");
        const float* __restrict__ xr = x; float* __restrict__ outr = out;
        float rr[2][4];
#pragma unroll
        for (int ai = 0; ai < 2; ++ai)
#pragma unroll
            for (int m = 0; m < 4; ++m) {
                const float* pp = part + (size_t)(row0 + ai * 128 + m * 16) * 16 + 4 * fq;
                float t = 0.f;
#pragma unroll
                for (int j = 0; j < 4; ++j) t += __hip_atomic_load(pp + j, __ATOMIC_RELAXED, __HIP_MEMORY_SCOPE_AGENT);
                rr[ai][m] = t;
            }
#pragma unroll
        for (int q = 0; q < 4; ++q) {
            const int ai = q >> 1, m0 = (q & 1) * 2;
            f32x4 xx[2][2][2];
#pragma unroll
            for (int mm = 0; mm < 2; ++mm)
#pragma unroll
                for (int bj = 0; bj < 2; ++bj)
#pragma unroll
                    for (int n = 0; n < 2; ++n) xx[mm][bj][n] = *(const f32x4*)(xr + (size_t)(row0 + ai * 128 + (m0 + mm) * 16) * DM + col0 + bj * 128 + n * 16);
            asm volatile("" ::: "memory");
#pragma unroll
            for (int mm = 0; mm < 2; ++mm) {
                const int m = m0 + mm;
                float t = rr[ai][m];
                t += __shfl_xor(t, 16); t += __shfl_xor(t, 32);
                const float r = rsqrtf(t * (1.0f / 1024.0f) + 1e-6f);
                const size_t off = (size_t)(row0 + ai * 128 + m * 16) * DM + col0;
#pragma unroll
                for (int bj = 0; bj < 2; ++bj)
#pragma unroll
                    for (int n = 0; n < 2; ++n) __builtin_nontemporal_store(xx[mm][bj][n] + acc[ai][bj][m][n] * r * gv[bj][n], (f32x4*)(outr + off + bj * 128 + n * 16));
            }
        }
    }
};

__device__ __forceinline__ float xhalf_max(float x) { const auto r = __builtin_amdgcn_permlane32_swap(__float_as_uint(x), __float_as_uint(x), false, false); return fmaxf(__uint_as_float(r[0]), __uint_as_float(r[1])); }
__device__ __forceinline__ float xhalf_sum(float x) { const auto r = __builtin_amdgcn_permlane32_swap(__float_as_uint(x), __float_as_uint(x), false, false); return __uint_as_float(r[0]) + __uint_as_float(r[1]); }
__device__ __forceinline__ int crow(int r, int h) { return (r & 3) + 8 * (r >> 2) + 4 * h; }
#define MFMA32(a, b, c) __builtin_amdgcn_mfma_f32_32x32x16_bf16((a), (b), (c), 0, 0, 0)

constexpr int PD = 1;
template <int MODE, int NKT>
__device__ __forceinline__ void attn_core(const bf16_t* __restrict__ qrow, const bf16_t* __restrict__ kb, const bf16_t* __restrict__ vb, const int ld, const int res, const int dil,
                                          const int kidx0, const int nq, const int maxd, float& m, float& l, f32x16& o0, f32x16& o1, LAS unsigned char* vl, const int lane) {
    const int c = lane & 31, h = lane >> 5;
    const int q4 = (lane & 15) >> 2, p4 = lane & 3, g2 = (lane >> 4) & 1;
    LAS unsigned char* trb = vl + (4 * h + q4) * VROWB + 32 * g2 + 8 * p4;
    const int vr = lane >> 3, vc = lane & 7;
    LAS unsigned char* vw = vl + vr * VROWB + vc * 16;
    LAS unsigned char* kw = vl + ST_K + vr * KROWB + vc * 16;
    LAS unsigned char* krd = vl + ST_K + c * KROWB + 16 * h;
    u32x4 kreg[PD][4]; u32x4 vreg[PD][4];
    const long tstep = (long)32 * dil * ld, istep = (long)8 * dil * ld;
    const bf16_t* kp = kb + ((long)(res + dil * (kidx0 + vr)) * ld + vc * 8);
    const bf16_t* vp = vb + ((long)(res + dil * (kidx0 + vr)) * ld + vc * 8);
#define LOAD_TILE(kt, sl) do { \
        _Pragma("unroll") for (int i = 0; i < 4; ++i) { \
            kreg[sl][i] = *(const u32x4*)(kp + (kt) * tstep + i * istep); vreg[sl][i] = *(const u32x4*)(vp + (kt) * tstep + i * istep); } } while (0)
#pragma unroll
    for (int t = 0; t < PD; ++t) if (t < NKT) LOAD_TILE(t, t);
    bf16x8 qf[4];
#pragma unroll
    for (int kk = 0; kk < 4; ++kk) qf[kk] = *(const bf16x8*)(qrow + 16 * kk + 8 * h);
    asm volatile("" ::: "memory");
#pragma unroll 1
    for (int kt0 = 0; kt0 < NKT; kt0 += PD) {
#pragma unroll
      for (int sl = 0; sl < PD; ++sl) {
        const int kt = kt0 + sl;
        if (kt < NKT) {
#pragma unroll
        for (int i = 0; i < 4; ++i) { *(LAS u32x4*)(kw + i * 8 * KROWB) = kreg[sl][i]; *(LAS u32x4*)(vw + i * 8 * VROWB) = vreg[sl][i]; }
        f32x16 s;
#pragma unroll
        for (int r = 0; r < 16; ++r) s[r] = 0.f;
#pragma unroll
        for (int kk = 0; kk < 4; ++kk) { const bf16x8 kfr = *(LAS bf16x8*)(krd + 32 * kk); s = MFMA32(kfr, qf[kk], s); }
        asm volatile("" ::: "memory");
        if (kt + PD < NKT) { LOAD_TILE(kt + PD, sl); }
        asm volatile("" ::: "memory");
        if (MODE != 2 && (kt == 0 || kt == NKT - 1)) {
            const int nkb = kidx0 + 32 * kt;
#pragma unroll
            for (int r = 0; r < 16; ++r) { const int nk = nkb + crow(r, h), dist = nq - nk; s[r] = (nk >= 0 && dist >= 0 && dist <= maxd) ? s[r] : -INFINITY; }
        } else if (MODE != 2) {
            const int nkb = kidx0 + 32 * kt;
            if (nkb < 0) {
#pragma unroll
                for (int r = 0; r < 16; ++r) { const int nk = nkb + crow(r, h); s[r] = nk >= 0 ? s[r] : -INFINITY; }
            }
        }
        float mx = s[0];
#pragma unroll
        for (int r = 1; r < 16; ++r) mx = fmaxf(mx, s[r]);
        mx = xhalf_max(mx);
        if (__builtin_amdgcn_ballot_w64(mx > m + 8.0f) != 0ull) {
            const float mnew = fmaxf(m, mx);
            const float alpha = mnew == -INFINITY ? 1.0f : __builtin_amdgcn_exp2f(m - mnew);
            l *= alpha; o0 *= alpha; o1 *= alpha; m = mnew;
        }
        const float mref = m == -INFINITY ? 0.f : m;
        float rs = 0.f;
#pragma unroll
        for (int r = 0; r < 16; ++r) { s[r] = __builtin_amdgcn_exp2f(s[r] - mref); rs += s[r]; }
        l += rs;
        bf16x8 pf[2];
#pragma unroll
        for (int s2 = 0; s2 < 2; ++s2) { u32x4 w; w.x = pack2(s[8 * s2], s[8 * s2 + 1]); w.y = pack2(s[8 * s2 + 2], s[8 * s2 + 3]); w.z = pack2(s[8 * s2 + 4], s[8 * s2 + 5]); w.w = pack2(s[8 * s2 + 6], s[8 * s2 + 7]);
            pf[s2] = __builtin_bit_cast(bf16x8, w); }
#pragma unroll
        for (int s2 = 0; s2 < 2; ++s2) {
            const s16x4 a0 = __builtin_amdgcn_ds_read_tr16_b64_v4i16((LAS s16x4*)(trb + (16 * s2) * VROWB));
            const s16x4 a1 = __builtin_amdgcn_ds_read_tr16_b64_v4i16((LAS s16x4*)(trb + (16 * s2 + 8) * VROWB));
            const s16x4 b0 = __builtin_amdgcn_ds_read_tr16_b64_v4i16((LAS s16x4*)(trb + (16 * s2) * VROWB + 64));
            const s16x4 b1 = __builtin_amdgcn_ds_read_tr16_b64_v4i16((LAS s16x4*)(trb + (16 * s2 + 8) * VROWB + 64));
            const bf16x8 va = __builtin_shufflevector(a0, a1, 0, 1, 2, 3, 4, 5, 6, 7), vbv = __builtin_shufflevector(b0, b1, 0, 1, 2, 3, 4, 5, 6, 7);
            o0 = MFMA32(va, pf[s2], o0);
            o1 = MFMA32(vbv, pf[s2], o1);
        }
        }
      }
    }
#undef LOAD_TILE
}

template <int NKT>
__device__ __forceinline__ void attn_core_img(const bf16_t* __restrict__ qrow, LAS unsigned char* kimg, LAS unsigned char* vimg, float& m, float& l, f32x16& o0, f32x16& o1, const int lane) {
    const int c = lane & 31, h = lane >> 5;
    const int q4 = (lane & 15) >> 2, p4 = lane & 3, g2 = (lane >> 4) & 1;
    LAS unsigned char* trb = vimg + (4 * h + q4) * VROWB + 32 * g2 + 8 * p4;
    LAS unsigned char* krd = kimg + c * KROWB + 16 * h;
    bf16x8 qf[4];
#pragma unroll
    for (int kk = 0; kk < 4; ++kk) qf[kk] = *(const bf16x8*)(qrow + 16 * kk + 8 * h);
#pragma unroll 1
    for (int kt = 0; kt < NKT; ++kt) {
        f32x16 s;
#pragma unroll
        for (int r = 0; r < 16; ++r) s[r] = 0.f;
#pragma unroll
        for (int kk = 0; kk < 4; ++kk) { const bf16x8 kfr = *(LAS bf16x8*)(krd + kt * 32 * KROWB + 32 * kk); s = MFMA32(kfr, qf[kk], s); }
        float mx = s[0];
#pragma unroll
        for (int r = 1; r < 16; ++r) mx = fmaxf(mx, s[r]);
        mx = xhalf_max(mx);
        if (__builtin_amdgcn_ballot_w64(mx > m + 8.0f) != 0ull) {
            const float mnew = fmaxf(m, mx);
            const float alpha = mnew == -INFINITY ? 1.0f : __builtin_amdgcn_exp2f(m - mnew);
            l *= alpha; o0 *= alpha; o1 *= alpha; m = mnew;
        }
        const float mref = m == -INFINITY ? 0.f : m;
        float rs = 0.f;
#pragma unroll
        for (int r = 0; r < 16; ++r) { s[r] = __builtin_amdgcn_exp2f(s[r] - mref); rs += s[r]; }
        l += rs;
        bf16x8 pf[2];
#pragma unroll
        for (int s2 = 0; s2 < 2; ++s2) { u32x4 w; w.x = pack2(s[8 * s2], s[8 * s2 + 1]); w.y = pack2(s[8 * s2 + 2], s[8 * s2 + 3]); w.z = pack2(s[8 * s2 + 4], s[8 * s2 + 5]); w.w = pack2(s[8 * s2 + 6], s[8 * s2 + 7]);
            pf[s2] = __builtin_bit_cast(bf16x8, w); }
        LAS unsigned char* tb = trb + kt * 32 * VROWB;
#pragma unroll
        for (int s2 = 0; s2 < 2; ++s2) {
            const s16x4 a0 = __builtin_amdgcn_ds_read_tr16_b64_v4i16((LAS s16x4*)(tb + (16 * s2) * VROWB));
            const s16x4 a1 = __builtin_amdgcn_ds_read_tr16_b64_v4i16((LAS s16x4*)(tb + (16 * s2 + 8) * VROWB));
            const s16x4 b0 = __builtin_amdgcn_ds_read_tr16_b64_v4i16((LAS s16x4*)(tb + (16 * s2) * VROWB + 64));
            const s16x4 b1 = __builtin_amdgcn_ds_read_tr16_b64_v4i16((LAS s16x4*)(tb + (16 * s2 + 8) * VROWB + 64));
            const bf16x8 va = __builtin_shufflevector(a0, a1, 0, 1, 2, 3, 4, 5, 6, 7), vbv = __builtin_shufflevector(b0, b1, 0, 1, 2, 3, 4, 5, 6, 7);
            o0 = MFMA32(va, pf[s2], o0);
            o1 = MFMA32(vbv, pf[s2], o1);
        }
    }
}

__device__ __forceinline__ float silu(float g) { return g * __builtin_amdgcn_rcpf(1.0f + __expf(-g)); }
__device__ __forceinline__ void attn_finalize(const f32x16& o0, const f32x16& o1, float l, const bf16_t* __restrict__ gtile, bf16_t* __restrict__ ytile, LAS unsigned char* vl, int lane) {
    const int c = lane & 31, h = lane >> 5, vr = lane >> 3, vc = lane & 7;
    u32x4 gv[4];
#pragma unroll
    for (int i = 0; i < 4; ++i) gv[i] = *(const u32x4*)(gtile + (size_t)(vr + 8 * i) * 64 + vc * 8);
    const float inv = __builtin_amdgcn_rcpf(l);
#pragma unroll
    for (int cc = 0; cc < 2; ++cc)
#pragma unroll
        for (int g = 0; g < 4; ++g) {
            const f32x16& o = cc ? o1 : o0;
            u32x2 w; w.x = pack2(o[4 * g] * inv, o[4 * g + 1] * inv); w.y = pack2(o[4 * g + 2] * inv, o[4 * g + 3] * inv);
            *(LAS u32x2*)(vl + c * 136 + (32 * cc + 8 * g + 4 * h) * 2) = w;
        }
#pragma unroll
    for (int i = 0; i < 4; ++i) {
        const int r = vr + 8 * i;
        const u32x2 lo = *(LAS u32x2*)(vl + r * 136 + vc * 16), hi = *(LAS u32x2*)(vl + r * 136 + vc * 16 + 8);
        const unsigned ov[4] = {lo.x, lo.y, hi.x, hi.y};
        u32x4 w;
#pragma unroll
        for (int j = 0; j < 4; ++j) { const float y0 = bflo(ov[j]) * bflo(gv[i][j]), y1 = bfhi(ov[j]) * bfhi(gv[i][j]); w[j] = pack2(y0, y1); }
        *(u32x4*)(ytile + (size_t)r * DM + vc * 8) = w;
    }
}

__device__ __forceinline__ void phase_attn(const Params& p, LAS unsigned char* lds, int rep, int item_lo, int item_hi, unsigned xcc) {
    const bf16_t* proj = (const bf16_t*)(p.ws + OFF_PROJ); const bf16_t* mkv = (const bf16_t*)(p.ws + OFF_MKV); bf16_t* Y = (bf16_t*)(p.ws + OFF_Y);
    unsigned* ctr = (unsigned*)(p.ws + OFF_CTR) + rep * 8;
    const int tid = threadIdx.x, lane = tid & 63, wid = tid >> 6, c = lane & 31, h = lane >> 5;
    LAS unsigned char* vl = lds + ST_V + wid * ST_VW;
    LAS int* item_s = (LAS int*)(lds + ST_ITEM);
    unsigned* memflag = (unsigned*)(p.ws + OFF_CNT) + 192;
    if (rep == 0 && blockIdx.x < 8) {
        pg8::Gemm g; g.A = (const bf16_t*)(p.ws + OFF_U); g.Bt = (const bf16_t*)(p.ws + OFF_WINT); g.M = NTOK; g.N = DIN; g.K = DM;
        MemUnit S; S.L = (int)blockIdx.x;
        EpiIn E; E.proj = (bf16_t*)(p.ws + OFF_PROJ); E.mkv = (bf16_t*)(p.ws + OFF_MKV); E.rope = (const float*)(p.ws + OFF_ROPE);
        pg8::gemm_phase<EpiIn, MemUnit, false>(lds, g, S, E, nullptr);
        asm volatile("s_waitcnt vmcnt(0)" ::: "memory");
        __syncthreads();
        if (tid == 0) { __threadfence(); __hip_atomic_fetch_add(memflag, 1u, __ATOMIC_RELAXED, __HIP_MEMORY_SCOPE_AGENT); }
    }
    unsigned* qctr = (unsigned*)(p.ws + OFF_QCTR) + rep * 8 * 64;
    int dq = 0;
    for (int itn = 0;; ++itn) {
        if (tid == 0) {
            int code = -1;
            while (dq < 8) {
                const int q_ = (int)((xcc + (unsigned)dq) & 7u);
                if (__hip_atomic_load(qctr + q_ * 64, __ATOMIC_RELAXED, __HIP_MEMORY_SCOPE_AGENT) < 128u) {
                    const int j_ = (int)atomicAdd(qctr + q_ * 64, 1u);
                    if (j_ < 128) { code = q_ * 128 + j_; break; }
                }
                ++dq;
            }
            item_s[itn & 1] = code;
        }
        __syncthreads();
        const int code = __builtin_amdgcn_readfirstlane(item_s[itn & 1]);
        if (code < 0) break;
        const int qi = code >> 7, j = code & 127;
        int item;
        if (j < 48) { const int pair = qi + 8 * (j >> 4), b_ = pair / 6, hd = pair - b_ * 6; item = (b_ * 16 + (j & 15)) * 6 + hd; }
        else if (j < 96) { const int jj = j - 48, b_ = qi >> 1, kvh_ = qi & 1, stl = jj / 3, g_ = jj - stl * 3; item = 640 + (b_ * 16 + stl) * 6 + kvh_ * 3 + g_; }
        else { const int jj = j - 96, pair = qi + 8 * (jj >> 4), b_ = pair >> 2, hd = pair & 3; item = 384 + (b_ * 16 + (jj & 15)) * 4 + hd; }
        if (item < item_lo || item >= item_hi) continue;
        if (wid >= 4) __builtin_amdgcn_s_sleep(12);
        if (item < 384) {
            const int st = item / 6, head = item - st * 6, b = st >> 4, t0 = (st & 15) * 512;
            const size_t hb = (size_t)b * SEQ * 64;
            const bf16_t* qh_ = proj + (size_t)(16 + head) * NTOK * 64 + hb; const bf16_t* kh_ = proj + (size_t)(22 + head) * NTOK * 64 + hb;
            const bf16_t* vh_ = proj + (size_t)(28 + head) * NTOK * 64 + hb; const bf16_t* gh_ = proj + (size_t)(34 + head) * NTOK * 64 + hb;
#pragma unroll 1
            for (int pass = 0; pass < 3; ++pass) {
                const int dil = pass == 0 ? 16 : (pass == 1 ? 4 : 1);
#pragma unroll 1
                for (int su = wid; su < 16; su += 8) {
                    int res, n0;
                    if (pass == 0) { res = su; n0 = t0 >> 4; } else if (pass == 1) { res = su & 3; n0 = (t0 >> 2) + 32 * (su >> 2); } else { res = 0; n0 = t0 + 32 * su; }
                    const int nq = n0 + c, posq = res + dil * nq, tokl = posq - t0, rowp = tokl ^ ((tokl >> 4) & 15);
                    LAS unsigned char* so = lds + rowp * ST_ROWB + 8 * h;
                    LAS float* sml = (LAS float*)(lds + ST_ML + rowp * 8);
                    float m, l; f32x16 o0, o1;
                    if (pass == 0) { m = -INFINITY; l = 0.f;
#pragma unroll
                        for (int r = 0; r < 16; ++r) { o0[r] = 0.f; o1[r] = 0.f; }
                    } else {
                        m = sml[0]; l = h == 0 ? sml[1] : 0.f;
#pragma unroll
                        for (int g = 0; g < 4; ++g) {
                            const u32x2 a = *(LAS u32x2*)(so + 16 * g), bb = *(LAS u32x2*)(so + 64 + 16 * g);
                            o0[4 * g] = bflo(a.x); o0[4 * g + 1] = bfhi(a.x); o0[4 * g + 2] = bflo(a.y); o0[4 * g + 3] = bfhi(a.y);
                            o1[4 * g] = bflo(bb.x); o1[4 * g + 1] = bfhi(bb.x); o1[4 * g + 2] = bflo(bb.y); o1[4 * g + 3] = bfhi(bb.y);
                        }
                    }
                    attn_core<1, 5>(qh_ + (size_t)posq * 64, kh_, vh_, 64, res, dil, n0 - 128, nq, 128, m, l, o0, o1, vl, lane);
                    l = xhalf_sum(l);
                    if (pass < 2) {
                        if (h == 0) { sml[0] = m; sml[1] = l; }
#pragma unroll
                        for (int g = 0; g < 4; ++g) {
                            u32x2 a, bb; a.x = pack2(o0[4 * g], o0[4 * g + 1]); a.y = pack2(o0[4 * g + 2], o0[4 * g + 3]); bb.x = pack2(o1[4 * g], o1[4 * g + 1]); bb.y = pack2(o1[4 * g + 2], o1[4 * g + 3]);
                            *(LAS u32x2*)(so + 16 * g) = a; *(LAS u32x2*)(so + 64 + 16 * g) = bb;
                        }
                    } else {
                        attn_finalize(o0, o1, l, gh_ + (size_t)n0 * 64, Y + ((size_t)b * SEQ + n0) * DM + 384 + head * 64, vl, lane);
                    }
                }
                if (pass < 2) __syncthreads();
            }
        } else if (item < 640) {
            const int idx = item - 384, st = idx >> 2, head = idx & 3, b = st >> 4, t0 = (st & 15) * 512;
            if (tid == 0) { unsigned sp = 0; while (__hip_atomic_load(memflag, __ATOMIC_RELAXED, __HIP_MEMORY_SCOPE_AGENT) < 8u && ++sp < (1u << 22)) __builtin_amdgcn_s_sleep(2); }
            __syncthreads();
            __builtin_amdgcn_fence(__ATOMIC_ACQUIRE, "agent");
            const bf16_t* kb = mkv + (size_t)b * 256 * 512 + head * 64;
            LAS unsigned char* kimg = lds + ST_V; LAS unsigned char* vimg = lds + ST_V + 256 * KROWB;
            {
                u32x4 kk_[4], vv_[4];
#pragma unroll
                for (int i = 0; i < 4; ++i) { const int ch = tid + 512 * i, row = ch >> 3, vc_ = ch & 7;
                    kk_[i] = *(const u32x4*)(kb + (size_t)row * 512 + vc_ * 8); vv_[i] = *(const u32x4*)(kb + 256 + (size_t)row * 512 + vc_ * 8); }
#pragma unroll
                for (int i = 0; i < 4; ++i) { const int ch = tid + 512 * i, row = ch >> 3, vc_ = ch & 7;
                    *(LAS u32x4*)(kimg + row * KROWB + vc_ * 16) = kk_[i]; *(LAS u32x4*)(vimg + row * VROWB + vc_ * 16) = vv_[i]; }
            }
            __syncthreads();
            LAS unsigned char* vfin = lds + wid * 4608;
#pragma unroll 1
            for (int su = wid; su < 16; su += 8) {
                const size_t row0 = (size_t)b * SEQ + t0 + 32 * su;
                float m = -INFINITY, l = 0.f; f32x16 o0, o1;
#pragma unroll
                for (int r = 0; r < 16; ++r) { o0[r] = 0.f; o1[r] = 0.f; }
                attn_core_img<8>(proj + ((size_t)(40 + head) * NTOK + row0 + c) * 64, kimg, vimg, m, l, o0, o1, lane);
                l = xhalf_sum(l);
                attn_finalize(o0, o1, l, proj + ((size_t)(44 + head) * NTOK + row0) * 64, Y + row0 * DM + 768 + head * 64, vfin, lane);
            }
        } else {
            const int idx = item - 640, st = idx / 6, qh = idx - st * 6, kvh = qh / 3, b = st >> 4, t0 = (st & 15) * 512;
            const size_t hb = (size_t)b * SEQ * 64;
            const bf16_t* qh_ = proj + (size_t)qh * NTOK * 64 + hb; const bf16_t* kh_ = proj + (size_t)(6 + kvh) * NTOK * 64 + hb;
            const bf16_t* vh_ = proj + (size_t)(8 + kvh) * NTOK * 64 + hb; const bf16_t* gh_ = proj + (size_t)(10 + qh) * NTOK * 64 + hb;
            const float sink = p.sink[qh] * 1.4426950408889634f;
#pragma unroll 1
            for (int su = wid; su < 16; su += 8) {
                const int n0 = t0 + 32 * su, nq = n0 + c;
                float m = sink, l = h == 0 ? 1.0f : 0.f; f32x16 o0, o1;
#pragma unroll
                for (int r = 0; r < 16; ++r) { o0[r] = 0.f; o1[r] = 0.f; }
                attn_core<0, 5>(qh_ + (size_t)nq * 64, kh_, vh_, 64, 0, 1, n0 - 128, nq, 127, m, l, o0, o1, vl, lane);
                l = xhalf_sum(l);
                attn_finalize(o0, o1, l, gh_ + (size_t)n0 * 64, Y + ((size_t)b * SEQ + n0) * DM + qh * 64, vl, lane);
            }
        }
    }
}

__device__ __forceinline__ void phase_post(const Params& p) {
    const int tid = threadIdx.x, lane = tid & 63, wid = tid >> 6, gw = blockIdx.x * 8 + wid, nw = gridDim.x * 8;
    const float* Z = (const float*)(p.ws + OFF_Z);
    for (int row = gw; row < NTOK; row += 2 * nw) {
        const int row2 = row + nw < NTOK ? row + nw : row;
        f32x4 v[4], w2[4], xa[4], xb2[4];
#pragma unroll
        for (int i = 0; i < 4; ++i) { v[i] = *(const f32x4*)(Z + (size_t)row * DM + i * 256 + lane * 4); w2[i] = *(const f32x4*)(Z + (size_t)row2 * DM + i * 256 + lane * 4);
                                      xa[i] = *(const f32x4*)(p.x + (size_t)row * DM + i * 256 + lane * 4); xb2[i] = *(const f32x4*)(p.x + (size_t)row2 * DM + i * 256 + lane * 4); }
        float ss = 0.f, ss2 = 0.f;
#pragma unroll
        for (int i = 0; i < 4; ++i) { ss += v[i][0] * v[i][0] + v[i][1] * v[i][1] + v[i][2] * v[i][2] + v[i][3] * v[i][3];
                                      ss2 += w2[i][0] * w2[i][0] + w2[i][1] * w2[i][1] + w2[i][2] * w2[i][2] + w2[i][3] * w2[i][3]; }
        ss = wave_sum(ss); ss2 = wave_sum(ss2);
        const float r = rsqrtf(ss * (1.0f / 1024.0f) + 1e-6f), r2 = rsqrtf(ss2 * (1.0f / 1024.0f) + 1e-6f);
#pragma unroll
        for (int i = 0; i < 4; ++i) {
            const f32x4 gg = *(const f32x4*)(p.post_g + i * 256 + lane * 4);
            *(f32x4*)(p.out + (size_t)row * DM + i * 256 + lane * 4) = xa[i] + v[i] * r * gg;
            *(f32x4*)(p.out + (size_t)row2 * DM + i * 256 + lane * 4) = xb2[i] + w2[i] * r2 * gg;
        }
    }
}


#define XB_TMO      128
#define XB_XCNT(j)  (256  + 64 * (j))
#define XB_XSUB(j)  (1280 + 64 * (j))
#define XB_XGEN(j)  (2304 + 64 * (j))
#define XB_TOP      3328
#define XB_TOPGEN   3392
#define XCD_BAR_WORDS 3456
#define XB_SPIN_CAP (1u << 18)

__device__ __forceinline__ unsigned xb_ld(unsigned* p)              { return __hip_atomic_load(p, __ATOMIC_RELAXED, __HIP_MEMORY_SCOPE_AGENT); }
__device__ __forceinline__ unsigned xb_add(unsigned* p, unsigned v) { return __hip_atomic_fetch_add(p, v, __ATOMIC_RELAXED, __HIP_MEMORY_SCOPE_AGENT); }
__device__ __forceinline__ unsigned xb_xcc_id() { return (unsigned)__builtin_amdgcn_s_getreg((3 << 11) | 20) & 0xFu; }
#define XB_SPIN(cond, bar) do { unsigned _sp = 0; while (cond) { __builtin_amdgcn_s_sleep(1); \
    if ((++_sp & 255u) == 0u) { if (xb_ld(&(bar)[XB_TMO])) break; if (_sp > XB_SPIN_CAP) { atomicAdd(&(bar)[XB_TMO], 1u); break; } } } } while (0)

struct XcdBarrier {
    unsigned* bar; unsigned x;
    volatile LAS unsigned* st;
};

__device__ __forceinline__ XcdBarrier xcd_barrier_post(unsigned* bar, volatile LAS unsigned* st) {
    XcdBarrier b; b.bar = bar; b.x = xb_xcc_id(); b.st = st;
    if (threadIdx.x == 0) (void)xb_add(&bar[XB_XCNT(b.x)], 1u);
    return b;
}
__device__ __forceinline__ void xcd_barrier_complete(unsigned* bar, unsigned x, unsigned& nloc, unsigned& nx) {
    const unsigned G = gridDim.x * gridDim.y * gridDim.z;
    unsigned sum, cnt, mine, sp = 0u;
    for (;;) {
        sum = 0u; cnt = 0u; mine = 0u;
#pragma unroll
        for (unsigned j = 0; j < 16; ++j) { const unsigned c = xb_ld(&bar[XB_XCNT(j)]); sum += c; cnt += (c > 0u) ? 1u : 0u; mine = (j == x) ? c : mine; }
        if (sum == G) break;
        __builtin_amdgcn_s_sleep(1);
        if ((++sp & 255u) == 0u) { if (xb_ld(&bar[XB_TMO])) break; if (sp > XB_SPIN_CAP) { atomicAdd(&bar[XB_TMO], 1u); break; } }
    }
    nloc = mine > 0u ? mine : 1u; nx = cnt > 0u ? cnt : 1u;
}

__device__ __forceinline__ void xcd_barrier(const XcdBarrier& b) {
    asm volatile("s_waitcnt vmcnt(0)" ::: "memory");
    __syncthreads();
    if (threadIdx.x == 0) {
        unsigned* bar = b.bar;
        __builtin_amdgcn_s_waitcnt(0);
        unsigned nloc = b.st[0], nx = b.st[1];
        if (nloc == 0u) { xcd_barrier_complete(bar, b.x, nloc, nx); b.st[0] = nloc; b.st[1] = nx; }
        const unsigned old = xb_add(&bar[XB_XSUB(b.x)], 1u);
        const unsigned gen = old / nloc;
        if (old + 1u == (gen + 1u) * nloc) {
            __builtin_amdgcn_fence(__ATOMIC_RELEASE, "agent");
            asm volatile("s_waitcnt vmcnt(0)" ::: "memory");
            const unsigned og = xb_add(&bar[XB_TOP], 1u);
            const unsigned tg = og / nx;
            if (og + 1u == (tg + 1u) * nx) xb_add(&bar[XB_TOPGEN], 1u);
            else XB_SPIN(xb_ld(&bar[XB_TOPGEN]) == tg, bar);
            __builtin_amdgcn_fence(__ATOMIC_ACQUIRE, "agent");
            xb_add(&bar[XB_XGEN(b.x)], 1u);
            asm volatile("s_waitcnt vmcnt(0)" ::: "memory");
        } else {
            XB_SPIN(xb_ld(&bar[XB_XGEN(b.x)]) == gen, bar);
            __builtin_amdgcn_fence(__ATOMIC_ACQUIRE, "agent");
            asm volatile("s_waitcnt vmcnt(0)" ::: "memory");
        }
    }
    __syncthreads();
}

__global__ __launch_bounds__(512, 2) void fwd_kernel(Params p) {
    extern __shared__ __attribute__((aligned(16))) unsigned char smem[];
    cg::grid_group grid = cg::this_grid();
    LAS unsigned char* lds = (LAS unsigned char*)smem;
    if (threadIdx.x < 4) ((LAS unsigned*)(lds + ST_XB))[threadIdx.x] = 0u;
    __syncthreads();
    const XcdBarrier xb = xcd_barrier_post((unsigned*)(p.ws + OFF_BAR), (volatile LAS unsigned*)(lds + ST_XB));
    if (p.out == nullptr) grid.sync();
#define GSYNC() xcd_barrier(xb)
#define GIN_BLOCK { \
        pg8::Gemm g; g.A = (const bf16_t*)(p.ws + OFF_U); g.Bt = (const bf16_t*)(p.ws + OFF_WINT); g.M = NTOK; g.N = DIN; g.K = DM; \
        pg8::StaticOrder S; S.init(NTOK, DIN, (int)gridDim.x, (int)blockIdx.x); \
        EpiIn E; E.proj = (bf16_t*)(p.ws + OFF_PROJ); E.mkv = (bf16_t*)(p.ws + OFF_MKV); E.rope = (const float*)(p.ws + OFF_ROPE); \
        pg8::gemm_phase<EpiIn, pg8::StaticOrder, false>(lds, g, S, E, nullptr); \
        GSYNC(); }
#define GOUT_BLOCK { \
        pg8::Gemm g; g.A = (const bf16_t*)(p.ws + OFF_Y); g.Bt = (const bf16_t*)(p.ws + OFF_WOUTT); g.M = NTOK; g.N = DM; g.K = DM; \
        OneUnit S; S.so.init(NTOK, DM, (int)gridDim.x, (int)blockIdx.x); \
        EpiOutFused E; E.x = p.x; E.g = p.post_g; E.out = p.out; E.part = (float*)(p.ws + OFF_PART); E.cnt = (unsigned*)(p.ws + OFF_CNT); \
        S.round = 0; pg8::gemm_phase<EpiOutFused, OneUnit, false>(lds, g, S, E, nullptr); \
        S.round = 1; pg8::gemm_phase<EpiOutFused, OneUnit, false>(lds, g, S, E, nullptr); }
    phase_prep(p); GSYNC();
#ifdef REP_SYNC
    GSYNC(); GSYNC(); GSYNC(); GSYNC(); GSYNC(); GSYNC(); GSYNC(); GSYNC();
#endif
#ifdef REP_PREP
    phase_prep(p); GSYNC();
#endif
    GIN_BLOCK
#if REP_GIN > 1
    GIN_BLOCK
#endif
    phase_attn(p, lds, 0, 0, 1024, xb.x); GSYNC();
#if REP_ATTN > 1
    phase_attn(p, lds, 1, REP_LO, REP_HI, xb.x); GSYNC();
#endif
    GOUT_BLOCK
#ifdef REP_GOUT
    if (gridDim.x == 256u) GOUT_BLOCK
    else {
        pg8::Gemm g; g.A = (const bf16_t*)(p.ws + OFF_Y); g.Bt = (const bf16_t*)(p.ws + OFF_WOUTT); g.M = NTOK; g.N = DM; g.K = DM;
        pg8::StaticOrder S; S.init(NTOK, DM, (int)gridDim.x, (int)blockIdx.x);
        pg8::EpiF32 E; E.C = (float*)(p.ws + OFF_Z); E.ldc = DM; E.bias = nullptr;
        pg8::gemm_phase<pg8::EpiF32, pg8::StaticOrder, false>(lds, g, S, E, nullptr);
        GSYNC();
        phase_post(p);
    }
#endif
}

extern "C" void kernel_launch(void* const* d_in, const int* in_sizes, int n_in, void* d_out, int out_size, void* d_ws, size_t ws_size, hipStream_t stream) {
    static int grid_blocks = 0;
    if (!grid_blocks) {
        int dev = 0, cus = 0, per_cu = 0;
        hipGetDevice(&dev);
        hipDeviceGetAttribute(&cus, hipDeviceAttributeMultiprocessorCount, dev);
        hipFuncSetAttribute((const void*)fwd_kernel, hipFuncAttributeMaxDynamicSharedMemorySize, LDS_BYTES);
        hipOccupancyMaxActiveBlocksPerMultiprocessor(&per_cu, (const void*)fwd_kernel, 512, LDS_BYTES);
        if (per_cu < 1) { fprintf(stderr, "occupancy query returned %d\n", per_cu); per_cu = 1; }
        grid_blocks = cus * per_cu;
    }
    Params p{};
    p.x = (const float*)d_in[0]; p.mem = (const float*)d_in[1]; p.pre_g = (const float*)d_in[2]; p.w_in = (const float*)d_in[3]; p.sink = (const float*)d_in[4];
    p.mem_g = (const float*)d_in[5]; p.w_memkv = (const float*)d_in[6]; p.w_out = (const float*)d_in[7]; p.post_g = (const float*)d_in[8];
    p.out = (float*)d_out; p.ws = (unsigned char*)d_ws;
    void* args[] = {&p};
    hipMemsetAsync((unsigned char*)d_ws + OFF_BAR, 0, 16384 + 8192, stream);
    hipError_t e = hipLaunchCooperativeKernel((const void*)fwd_kernel, dim3(grid_blocks), dim3(512), args, LDS_BYTES, stream);
    if (e != hipSuccess) fprintf(stderr, "cooperative launch failed: %s (grid %d)\n", hipGetErrorString(e), grid_blocks);
}
```

```cpp
#include <hip/hip_runtime.h>
#include <hip/hip_cooperative_groups.h>
#include <cstdio>
namespace cg = cooperative_groups;
namespace pg8 {
#define PG8_LAS __attribute__((address_space(3)))
typedef unsigned short bf16_t;
typedef short bf16x8 __attribute__((ext_vector_type(8)));
typedef float f32x4 __attribute__((ext_vector_type(4)));
typedef unsigned u32x4 __attribute__((ext_vector_type(4)));
constexpr int BM = 256, BK = 64, HALF = 128, HTB = HALF * BK * 2  , STAGE_BYTES = 8 * HTB, NXCD = 8, WGM = 8;

__host__ __device__ __forceinline__ int lds_byte(int r, int c) { const int st = (r >> 4) * 2 + (c >> 5), rr = r & 15, cc = c & 31, ob = rr * 64 + cc * 2; return st * 1024 + (ob ^ (((ob >> 9) & 1) << 5)); }
__host__ __device__ __forceinline__ void stage_rc(int b, int& R, int& C) { const int st = b / 1024, sb = b % 1024, swz = sb ^ (((sb >> 9) & 1) << 5); R = (st >> 1) * 16 + swz / 64; C = (st & 1) * 32 + (swz % 64) / 2; }
__host__ __device__ __forceinline__ int perm32(int rho) { const int n = rho >> 4, i = rho & 15; return 8 * (i >> 2) + 4 * n + (i & 3); }

struct Unit { int pm, pn; };
struct Gemm { const bf16_t* A; const bf16_t* Bt; int M, N, K; };
struct StaticOrder {
    int nM, nN, nwg, G, c;
    __host__ __device__ void init(int M, int N, int G_, int c_) { nM = M / BM; nN = N / BM; nwg = nM * nN; G = G_; c = c_; }
    __host__ __device__ bool next(int i, Unit& u) const {
        const long L = (long)i * G + c; if (L >= nwg) return false;
        int wgid = (int)L; { const int q = nwg / NXCD, r = nwg % NXCD, xcd = wgid % NXCD, off = wgid / NXCD; wgid = (xcd < r ? xcd * (q + 1) : r * (q + 1) + (xcd - r) * q) + off; }
        const int nig = WGM * nN, gid = wgid / nig, fm = gid * WGM, gsz = (nM - fm) < WGM ? (nM - fm) : WGM;
        u.pm = fm + ((wgid % nig) % gsz); u.pn = (wgid % nig) / gsz; return true;
    }
    __device__ __forceinline__ void a_ready(const Unit&) const {}
    __device__ __forceinline__ void done(const Unit&) const {}
};
__device__ __forceinline__ unsigned cvt_pk_bf16(float lo, float hi) { unsigned r; asm volatile("v_cvt_pk_bf16_f32 %0, %1, %2" : "=v"(r) : "v"(lo), "v"(hi)); return r; }
struct EpiF32 {
    static constexpr bool PERM = false, AFTER_DRAIN = false;
    float* C; int ldc; const float* bias;
    __device__ __forceinline__ void operator()(const f32x4 (&acc)[2][2][4][2], const Unit& u, int wr, int wc, int fr, int fq) const {
        const int row0 = u.pm * BM + wr * 64 + fr, col0 = u.pn * BM + wc * 32 + 4 * fq;
        f32x4 bv[2][2];
#pragma unroll
        for (int bj = 0; bj < 2; ++bj)
#pragma unroll
            for (int n = 0; n < 2; ++n) bv[bj][n] = bias ? *(const f32x4*)(bias + col0 + bj * HALF + n * 16) : (f32x4){0.f, 0.f, 0.f, 0.f};
#pragma unroll
        for (int ai = 0; ai < 2; ++ai)
#pragma unroll
            for (int m = 0; m < 4; ++m) { float* rowp = C + (size_t)(row0 + ai * HALF + m * 16) * ldc + col0;
#pragma unroll
                for (int bj = 0; bj < 2; ++bj)
#pragma unroll
                    for (int n = 0; n < 2; ++n) *(f32x4*)(rowp + bj * HALF + n * 16) = acc[ai][bj][m][n] + bv[bj][n]; }
    }
};
template <class Epi, class Sched, bool STAMP = false>
__device__ __forceinline__ void gemm_phase(PG8_LAS unsigned char* lds, const Gemm g, const Sched& S, const Epi& E, unsigned long long* stamps) {
    const int tid = threadIdx.x, wid = __builtin_amdgcn_readfirstlane(tid >> 6), lane = tid & 63, wr = wid >> 2, wc = wid & 3, fr = lane & 15, fq = lane >> 4;
    const int K = g.K, nt = K / BK;
#define PG8_STAMP() do {} while (0)
    unsigned voffA[2], voffB[2];
#pragma unroll
    for (int i = 0; i < 2; ++i) { int R, C; stage_rc(tid * 16 + i * 8192, R, C); const int Rb = Epi::PERM ? ((R & ~31) + perm32(R & 31)) : R;
        voffA[i] = (unsigned)(R * K + C) * 2u; voffB[i] = (unsigned)(Rb * K + C) * 2u; }
    const size_t kstep = (size_t)(BK * 2);
    const size_t hstep = (size_t)HALF * K * 2;
    const size_t tstep = 2 * hstep;
    const unsigned ldsw = (unsigned)wid * 1024u;
    const int aoff = lds_byte(wr * 64 + fr, fq * 8), boff = lds_byte(wc * 32 + fr, fq * 8);
#define PG8_SA(b, h) (((b) * 2 + (h)) * HTB)
#define PG8_SB(b, h) ((4 + (b) * 2 + (h)) * HTB)
#define PG8_STAGE(bufoff, gbase, voff) do { _Pragma("unroll") for (int _i = 0; _i < 2; ++_i) \
        __builtin_amdgcn_global_load_lds((const unsigned*)((const char*)(gbase) + (voff)[_i]), (PG8_LAS unsigned*)(lds + (bufoff) + ldsw + _i * 8192), 16, 0, 0); } while (0)
#define PG8_LDA(dst, b, h) do { _Pragma("unroll") for (int m = 0; m < 4; ++m) _Pragma("unroll") for (int k = 0; k < 2; ++k) dst[m][k] = *(const PG8_LAS bf16x8*)(lds + PG8_SA(b, h) + aoff + m * 2048 + k * 1024); } while (0)
#define PG8_LDB(dst, b, h) do { _Pragma("unroll") for (int n = 0; n < 2; ++n) _Pragma("unroll") for (int k = 0; k < 2; ++k) dst[n][k] = *(const PG8_LAS bf16x8*)(lds + PG8_SB(b, h) + boff + n * 2048 + k * 1024); } while (0)
#define PG8_MMA(ai, bj, At, Bt) do { __builtin_amdgcn_s_setprio(1); _Pragma("unroll") for (int m = 0; m < 4; ++m) _Pragma("unroll") for (int n = 0; n < 2; ++n) _Pragma("unroll") for (int k = 0; k < 2; ++k) \
        acc[ai][bj][m][n] = __builtin_amdgcn_mfma_f32_16x16x32_bf16(Bt[n][k], At[m][k], acc[ai][bj][m][n], 0, 0, 0); __builtin_amdgcn_s_setprio(0); } while (0)
#define PG8_WAIT_V(n) asm volatile("s_waitcnt vmcnt(" #n ")" ::: "memory")
#define PG8_WAIT_L(n) asm volatile("s_waitcnt lgkmcnt(" #n ")" ::: "memory")
#define PG8_BAR __builtin_amdgcn_s_barrier()
#define PG8_SCHED __builtin_amdgcn_sched_barrier(0)
    Unit cur, nxt; int ui = 0;
    if (!S.next(0, cur)) return;
    f32x4 acc[2][2][4][2];
#pragma unroll
    for (int a = 0; a < 2; ++a)
#pragma unroll
        for (int b = 0; b < 2; ++b)
#pragma unroll
            for (int m = 0; m < 4; ++m)
#pragma unroll
                for (int n = 0; n < 2; ++n) acc[a][b][m][n] = (f32x4){0.f, 0.f, 0.f, 0.f};
    bf16x8 At[4][2], B0[2][2], B1[2][2];
    const char* cA = (const char*)g.A + (size_t)cur.pm * tstep; const char* cB = (const char*)g.Bt + (size_t)cur.pn * tstep;
    S.a_ready(cur);
    PG8_STAGE(PG8_SB(0, 0), cB, voffB); PG8_STAGE(PG8_SA(0, 0), cA, voffA); PG8_STAGE(PG8_SB(0, 1), cB + hstep, voffB); PG8_STAGE(PG8_SA(0, 1), cA + hstep, voffA);
    if (wr == 1) PG8_BAR;
    PG8_WAIT_V(4); PG8_BAR;
    PG8_STAGE(PG8_SB(1, 0), cB + kstep, voffB); PG8_STAGE(PG8_SA(1, 0), cA + kstep, voffA); PG8_STAGE(PG8_SB(1, 1), cB + hstep + kstep, voffB);
    PG8_WAIT_V(6); PG8_BAR;
    PG8_STAMP();
    for (;;) {
        const bool has_next = S.next(ui + 1, nxt);
        const char* nA = has_next ? (const char*)g.A + (size_t)nxt.pm * tstep : cA; const char* nB = has_next ? (const char*)g.Bt + (size_t)nxt.pn * tstep : cB;
        for (int t = 0; t < nt; t += 2) {
            const bool last = (t == nt - 2);
            const char* a1 = cA + (size_t)(t + 1) * kstep;
            const char* a2 = last ? nA : cA + (size_t)(t + 2) * kstep; const char* b2 = last ? nB : cB + (size_t)(t + 2) * kstep;
            const char* a3 = a2 + kstep; const char* b3 = b2 + kstep;
            if (last && has_next) S.a_ready(nxt);
            PG8_LDB(B0, 0, 0); PG8_SCHED; PG8_LDA(At, 0, 0); PG8_STAGE(PG8_SA(1, 1), a1 + hstep, voffA);
            PG8_WAIT_L(8); PG8_BAR; PG8_WAIT_L(0); PG8_MMA(0, 0, At, B0); PG8_BAR; PG8_SCHED;
            PG8_LDB(B1, 0, 1); PG8_STAGE(PG8_SB(0, 0), b2, voffB);
            PG8_BAR; PG8_WAIT_L(0); PG8_MMA(0, 1, At, B1); PG8_BAR;
            PG8_LDA(At, 0, 1); PG8_STAGE(PG8_SA(0, 0), a2, voffA);
            PG8_BAR; PG8_WAIT_L(0); PG8_MMA(1, 0, At, B0); PG8_BAR; PG8_SCHED;
            PG8_STAGE(PG8_SB(0, 1), b2 + hstep, voffB);
            PG8_WAIT_V(6); PG8_BAR; PG8_MMA(1, 1, At, B1); PG8_BAR;
            PG8_LDB(B0, 1, 0); PG8_SCHED; PG8_LDA(At, 1, 0); PG8_STAGE(PG8_SA(0, 1), a2 + hstep, voffA);
            PG8_WAIT_L(8); PG8_BAR; PG8_WAIT_L(0); PG8_MMA(0, 0, At, B0); PG8_BAR; PG8_SCHED;
            PG8_LDB(B1, 1, 1); PG8_STAGE(PG8_SB(1, 0), b3, voffB);
            PG8_BAR; PG8_WAIT_L(0); PG8_MMA(0, 1, At, B1); PG8_BAR;
            PG8_LDA(At, 1, 1); PG8_STAGE(PG8_SA(1, 0), a3, voffA);
            PG8_BAR; PG8_WAIT_L(0); PG8_MMA(1, 0, At, B0); PG8_BAR; PG8_SCHED;
            PG8_STAGE(PG8_SB(1, 1), b3 + hstep, voffB);
            PG8_WAIT_V(6); PG8_BAR; PG8_MMA(1, 1, At, B1); PG8_BAR;
        }
        PG8_STAMP();
        if constexpr (!Epi::AFTER_DRAIN) { E(acc, cur, wr, wc, fr, fq); S.done(cur); }
        PG8_STAMP();
        if (!has_next) break;
#pragma unroll
        for (int a = 0; a < 2; ++a)
#pragma unroll
            for (int b = 0; b < 2; ++b)
#pragma unroll
                for (int m = 0; m < 4; ++m)
#pragma unroll
                    for (int n = 0; n < 2; ++n) acc[a][b][m][n] = (f32x4){0.f, 0.f, 0.f, 0.f};
        cur = nxt; cA = nA; cB = nB; ++ui;
    }
    PG8_WAIT_V(0);
    if (wr == 0) PG8_BAR;
    PG8_BAR;
    if constexpr (Epi::AFTER_DRAIN) { E.fused(acc, cur, wr, wc, fr, fq, lds, wid, lane); S.done(cur); }
    PG8_STAMP();
#undef PG8_STAMP
#undef PG8_SA
#undef PG8_SB
#undef PG8_STAGE
#undef PG8_LDA
#undef PG8_LDB
#undef PG8_MMA
#undef PG8_WAIT_V
#undef PG8_WAIT_L
#undef PG8_BAR
#undef PG8_SCHED
}
}
using pg8::bf16_t; using pg8::bf16x8; using pg8::f32x4; using pg8::u32x4; using pg8::Unit;
#define LAS __attribute__((address_space(3)))
typedef short s16x4 __attribute__((ext_vector_type(4)));
typedef float f32x16 __attribute__((ext_vector_type(16)));
typedef float f32x2 __attribute__((ext_vector_type(2)));
typedef __bf16 bf16x2_t __attribute__((ext_vector_type(2)));
typedef unsigned u32x2 __attribute__((ext_vector_type(2)));

constexpr int NTOK = 32768, SEQ = 8192, DM = 1024, DIN = 3072, MROWS = 32768 + 1024;
constexpr size_t OFF_U = 0, OFF_WINT = 69206016, OFF_WOUTT = 76546048, OFF_ROPE = 78643200, OFF_MKV = 79167488, OFF_CTR = 80216064,
                 OFF_Y = OFF_U  , OFF_PROJ = 147325184, OFF_Z = OFF_PROJ, OFF_BAR = 348651776, OFF_CNT = OFF_BAR + 16384, OFF_QCTR = OFF_CNT + 1024, OFF_PART = OFF_CNT + 8192;
#ifndef REP_ATTN
#define REP_ATTN 1
#endif
#ifndef REP_GIN
#define REP_GIN 1
#endif
#ifndef REP_MISC
#define REP_MISC 1
#endif
constexpr int LDS_BYTES = 159776;
constexpr int ST_ROWB = 136, ST_ML = 69632, ST_V = 73728, ST_VW = 10752, ST_K = 6144, ST_ITEM = 159744, ST_XB = 159760, VROWB = 192, KROWB = 144;

struct Params { const float *x, *mem, *pre_g, *w_in, *sink, *mem_g, *w_memkv, *w_out, *post_g; float* out; unsigned char* ws; };

__device__ __forceinline__ unsigned pack2(float lo, float hi) { f32x2 v; v.x = lo; v.y = hi; return __builtin_bit_cast(unsigned, __builtin_convertvector(v, bf16x2_t)); }
__device__ __forceinline__ float bflo(unsigned w) { return __uint_as_float(w << 16); }
__device__ __forceinline__ float bfhi(unsigned w) { return __uint_as_float(w & 0xffff0000u); }
__device__ __forceinline__ float wave_sum(float v) {
#pragma unroll
    for (int o = 32; o >= 1; o >>= 1) v += __shfl_xor(v, o);
    return v;
}

__device__ __forceinline__ void transpose_tile(const float* __restrict__ W, int N, bf16_t* __restrict__ WT, int task, int lane) {
    const int ntn = N >> 6, k0 = (task / ntn) * 64, n = (task % ntn) * 64 + lane;
    const float* src = W + (size_t)k0 * N + n;
    float v[64];
#pragma unroll
    for (int r = 0; r < 64; ++r) v[r] = __builtin_nontemporal_load(src + (size_t)r * N);
    bf16_t* dst = WT + (size_t)n * 1024 + k0;
#pragma unroll
    for (int q = 0; q < 8; ++q) {
        u32x4 w; w.x = pack2(v[8 * q], v[8 * q + 1]); w.y = pack2(v[8 * q + 2], v[8 * q + 3]); w.z = pack2(v[8 * q + 4], v[8 * q + 5]); w.w = pack2(v[8 * q + 6], v[8 * q + 7]);
        *(u32x4*)(dst + 8 * q) = w;
    }
}
__device__ __forceinline__ void phase_prep(const Params& p) {
    const int tid = threadIdx.x, lane = tid & 63, wid = tid >> 6;
    const int gw = blockIdx.x * 8 + wid, nw = gridDim.x * 8, gt = blockIdx.x * 512 + tid, nt = gridDim.x * 512;
    bf16_t* U = (bf16_t*)(p.ws + OFF_U);
    if (blockIdx.x == 0 && tid < 2) ((unsigned*)(p.ws + OFF_CTR))[tid * 8] = 0u;
    for (int row = gw; row < MROWS; row += 2 * nw) {
        const int row2 = row + nw < MROWS ? row + nw : row;
        const float* src = row < NTOK ? p.x + (size_t)row * DM : p.mem + (size_t)(row - NTOK) * DM;
        const float* src2 = row2 < NTOK ? p.x + (size_t)row2 * DM : p.mem + (size_t)(row2 - NTOK) * DM;
        const float* g = row < NTOK ? p.pre_g : p.mem_g;
        const float* g2 = row2 < NTOK ? p.pre_g : p.mem_g;
        f32x4 v[4], w2[4];
#pragma unroll
        for (int i = 0; i < 4; ++i) { v[i] = __builtin_nontemporal_load((const f32x4*)(src + i * 256 + lane * 4)); w2[i] = __builtin_nontemporal_load((const f32x4*)(src2 + i * 256 + lane * 4)); }
        float ss = 0.f, ss2 = 0.f;
#pragma unroll
        for (int i = 0; i < 4; ++i) { ss += v[i][0] * v[i][0] + v[i][1] * v[i][1] + v[i][2] * v[i][2] + v[i][3] * v[i][3];
                                      ss2 += w2[i][0] * w2[i][0] + w2[i][1] * w2[i][1] + w2[i][2] * w2[i][2] + w2[i][3] * w2[i][3]; }
        ss = wave_sum(ss); ss2 = wave_sum(ss2);
        const float r = rsqrtf(ss * (1.0f / 1024.0f) + 1e-6f), r2 = rsqrtf(ss2 * (1.0f / 1024.0f) + 1e-6f);
#pragma unroll
        for (int i = 0; i < 4; ++i) {
            const f32x4 gg = *(const f32x4*)(g + i * 256 + lane * 4), gg2 = *(const f32x4*)(g2 + i * 256 + lane * 4);
            u32x2 w; w.x = pack2(v[i][0] * r * gg[0], v[i][1] * r * gg[1]); w.y = pack2(v[i][2] * r * gg[2], v[i][3] * r * gg[3]);
            *(u32x2*)(U + (size_t)row * DM + i * 256 + lane * 4) = w;
            u32x2 y; y.x = pack2(w2[i][0] * r2 * gg2[0], w2[i][1] * r2 * gg2[1]); y.y = pack2(w2[i][2] * r2 * gg2[2], w2[i][3] * r2 * gg2[3]);
            *(u32x2*)(U + (size_t)row2 * DM + i * 256 + lane * 4) = y;
        }
    }
    bf16_t* WinT = (bf16_t*)(p.ws + OFF_WINT);
    for (int task = gw; task < 768 + 128 + 256; task += nw) {
        if (task < 768) transpose_tile(p.w_in, 3072, WinT, task, lane);
        else if (task < 896) transpose_tile(p.w_memkv, 512, WinT + (size_t)3072 * 1024, task - 768, lane);
        else transpose_tile(p.w_out, 1024, (bf16_t*)(p.ws + OFF_WOUTT), task - 896, lane);
    }
    float* rope = (float*)(p.ws + OFF_ROPE);
    for (int it = gt; it < SEQ * 8; it += nt) {
        const int pos = it >> 3, i = it & 7;
        const float inv = i == 0 ? 1.0f : i == 1 ? 0x1.8d275ep-3f : i == 2 ? 0x1.341190p-5f : i == 3 ? 0x1.ddee9cp-8f : i == 4 ? 0x1.72ba44p-10f : i == 5 ? 0x1.1f91f0p-12f : i == 6 ? 0x1.be2188p-15f : 0x1.5a0f4ep-17f;
        const float ang = (float)pos * inv;
        rope[pos * 16 + i] = cosf(ang); rope[pos * 16 + 8 + i] = sinf(ang);
    }
}

struct MemUnit {
    int L;
    __device__ bool next(int i, Unit& u) const { if (i != 0) return false; u.pm = 128 + (L >> 1); u.pn = 12 + (L & 1); return true; }
    __device__ __forceinline__ void a_ready(const Unit&) const {}
    __device__ __forceinline__ void done(const Unit&) const {}
};
struct EpiIn {
    static constexpr bool PERM = true, AFTER_DRAIN = false;
    bf16_t* proj; bf16_t* mkv; const float* rope;
    __device__ __forceinline__ void operator()(const f32x4 (&acc)[2][2][4][2], const Unit& u, int wr, int wc, int fr, int fq) const {
        if (u.pm >= 128) {
            const int row0 = (u.pm - 128) * 256 + wr * 64 + fr, col0 = (u.pn - 12) * 256 + wc * 32 + 8 * fq;
#pragma unroll
            for (int ai = 0; ai < 2; ++ai)
#pragma unroll
                for (int m = 0; m < 4; ++m) { bf16_t* rowp = mkv + (size_t)(row0 + ai * 128 + m * 16) * 512 + col0;
#pragma unroll
                    for (int bj = 0; bj < 2; ++bj) { const f32x4 v0 = acc[ai][bj][m][0], v1 = acc[ai][bj][m][1];
                        u32x4 w; w.x = pack2(v0[0], v0[1]); w.y = pack2(v0[2], v0[3]); w.z = pack2(v1[0], v1[1]); w.w = pack2(v1[2], v1[3]);
                        *(u32x4*)(rowp + bj * 128) = w; } }
            return;
        }
        const int row0 = u.pm * 256 + wr * 64 + fr;
        bf16_t* __restrict__ projr = proj; const float* __restrict__ roper = rope;
#pragma unroll
        for (int bj = 0; bj < 2; ++bj) {
            const int cg0 = u.pn * 256 + bj * 128 + wc * 32;
            const float scale = (cg0 < 384 || (cg0 >= 1024 && cg0 < 1408) || (cg0 >= 2560 && cg0 < 2816)) ? 0.18033688011112042f : 1.0f;
            const bool rope_on = (cg0 < 512 || (cg0 >= 1024 && cg0 < 1792)) && ((cg0 & 63) == 0);
            const bool gate_cols = (cg0 >= 640 && cg0 < 1024) || (cg0 >= 2176 && cg0 < 2560) || cg0 >= 2816;
#pragma unroll
            for (int ai = 0; ai < 2; ++ai)
#pragma unroll
                for (int m = 0; m < 4; ++m) {
                    const int row = row0 + ai * 128 + m * 16;
                    f32x4 v0 = acc[ai][bj][m][0], v1 = acc[ai][bj][m][1];
                    if (rope_on) {
                        f32x4 p0, p1;
#pragma unroll
                        for (int j = 0; j < 4; ++j) { p0[j] = __shfl_xor(v0[j], 16); p1[j] = __shfl_xor(v1[j], 16); }
                        if (fq < 2) {
                            const float* cs = roper + (size_t)(row & (SEQ - 1)) * 16;
                            const f32x4 c0 = *(const f32x4*)(cs), c1 = *(const f32x4*)(cs + 4), s0 = *(const f32x4*)(cs + 8), s1 = *(const f32x4*)(cs + 12);
                            const float sg = fq == 0 ? -1.0f : 1.0f;
                            v0 = v0 * c0 + sg * (p0 * s0); v1 = v1 * c1 + sg * (p1 * s1);
                        }
                    }
                    v0 *= scale; v1 *= scale;
                    if (gate_cols) {
#pragma unroll
                        for (int j = 0; j < 4; ++j) { v0[j] = v0[j] * __builtin_amdgcn_rcpf(1.0f + __expf(-v0[j])); v1[j] = v1[j] * __builtin_amdgcn_rcpf(1.0f + __expf(-v1[j])); }
                    }
                    u32x4 w; w.x = pack2(v0[0], v0[1]); w.y = pack2(v0[2], v0[3]); w.z = pack2(v1[0], v1[1]); w.w = pack2(v1[2], v1[3]);
                    *(u32x4*)(projr + ((size_t)(cg0 >> 6) * NTOK + row) * 64 + (cg0 & 63) + 8 * fq) = w;
                }
        }
    }
};

struct OneUnit {
    pg8::StaticOrder so; int round;
    __device__ bool next(int i, Unit& u) const { return i == 0 ? so.next(round, u) : false; }
    __device__ __forceinline__ void a_ready(const Unit&) const {}
    __device__ __forceinline__ void done(const Unit&) const {}
};
struct EpiOutFused {
    static constexpr bool PERM = false, AFTER_DRAIN = true;
    const float* x; const float* g; float* out; float* part; unsigned* cnt;
    __device__ __forceinline__ void fused(const f32x4 (&acc)[2][2][4][2], const Unit& u, int wr, int wc, int fr, int fq, LAS unsigned char*, int, int) const {
        const int row0 = u.pm * 256 + wr * 64 + fr, col0 = u.pn * 256 + wc * 32 + 4 * fq;
#pragma unroll
        for (int ai = 0; ai < 2; ++ai)
#pragma unroll
            for (int m = 0; m < 4; ++m) {
                float ss = 0.f;
#pragma unroll
                for (int bj = 0; bj < 2; ++bj)
#pragma unroll
                    for (int n = 0; n < 2; ++n) { const f32x4 v = acc[ai][bj][m][n]; ss += v[0] * v[0] + v[1] * v[1] + v[2] * v[2] + v[3] * v[3]; }
                ss += __shfl_xor(ss, 16); ss += __shfl_xor(ss, 32);
                if (fq == 0) __hip_atomic_store(part + (size_t)(row0 + ai * 128 + m * 16) * 16 + u.pn * 4 + wc, ss, __ATOMIC_RELAXED, __HIP_MEMORY_SCOPE_AGENT);
            }
        asm volatile("s_waitcnt vmcnt(0)" ::: "memory");
        __syncthreads();
        if (threadIdx.x == 0) {
            __hip_atomic_fetch_add(cnt + u.pm, 1u, __ATOMIC_RELAXED, __HIP_MEMORY_SCOPE_AGENT);
            unsigned sp = 0; while (__hip_atomic_load(cnt + u.pm, __ATOMIC_RELAXED, __HIP_MEMORY_SCOPE_AGENT) < 4u && ++sp < (1u << 22)) __builtin_amdgcn_s_sleep(2);
        }
        f32x4 gv[2][2];
#pragma unroll
        for (int bj = 0; bj < 2; ++bj)
#pragma unroll
            for (int n = 0; n < 2; ++n) gv[bj][n] = *(const f32x4*)(g + col0 + bj * 128 + n * 16);
        __syncthreads();
        asm volatile("" ::: "memory");
        const float* __restrict__ xr = x; float* __restrict__ outr = out;
        float rr[2][4];
#pragma unroll
        for (int ai = 0; ai < 2; ++ai)
#pragma unroll
            for (int m = 0; m < 4; ++m) {
                const float* pp = part + (size_t)(row0 + ai * 128 + m * 16) * 16 + 4 * fq;
                float t = 0.f;
#pragma unroll
                for (int j = 0; j < 4; ++j) t += __hip_atomic_load(pp + j, __ATOMIC_RELAXED, __HIP_MEMORY_SCOPE_AGENT);
                rr[ai][m] = t;
            }
#pragma unroll
        for (int q = 0; q < 4; ++q) {
            const int ai = q >> 1, m0 = (q & 1) * 2;
            f32x4 xx[2][2][2];
#pragma unroll
            for (int mm = 0; mm < 2; ++mm)
#pragma unroll
                for (int bj = 0; bj < 2; ++bj)
#pragma unroll
                    for (int n = 0; n < 2; ++n) xx[mm][bj][n] = *(const f32x4*)(xr + (size_t)(row0 + ai * 128 + (m0 + mm) * 16) * DM + col0 + bj * 128 + n * 16);
            asm volatile("" ::: "memory");
#pragma unroll
            for (int mm = 0; mm < 2; ++mm) {
                const int m = m0 + mm;
                float t = rr[ai][m];
                t += __shfl_xor(t, 16); t += __shfl_xor(t, 32);
                const float r = rsqrtf(t * (1.0f / 1024.0f) + 1e-6f);
                const size_t off = (size_t)(row0 + ai * 128 + m * 16) * DM + col0;
#pragma unroll
                for (int bj = 0; bj < 2; ++bj)
#pragma unroll
                    for (int n = 0; n < 2; ++n) __builtin_nontemporal_store(xx[mm][bj][n] + acc[ai][bj][m][n] * r * gv[bj][n], (f32x4*)(outr + off + bj * 128 + n * 16));
            }
        }
    }
};

__device__ __forceinline__ float xhalf_max(float x) { const auto r = __builtin_amdgcn_permlane32_swap(__float_as_uint(x), __float_as_uint(x), false, false); return fmaxf(__uint_as_float(r[0]), __uint_as_float(r[1])); }
__device__ __forceinline__ float xhalf_sum(float x) { const auto r = __builtin_amdgcn_permlane32_swap(__float_as_uint(x), __float_as_uint(x), false, false); return __uint_as_float(r[0]) + __uint_as_float(r[1]); }
__device__ __forceinline__ int crow(int r, int h) { return (r & 3) + 8 * (r >> 2) + 4 * h; }
#define MFMA32(a, b, c) __builtin_amdgcn_mfma_f32_32x32x16_bf16((a), (b), (c), 0, 0, 0)

constexpr int PD = 1;
template <int MODE, int NKT>
__device__ __forceinline__ void attn_core(const bf16_t* __restrict__ qrow, const bf16_t* __restrict__ kb, const bf16_t* __restrict__ vb, const int ld, const int res, const int dil,
                                          const int kidx0, const int nq, const int maxd, float& m, float& l, f32x16& o0, f32x16& o1, LAS unsigned char* vl, const int lane, const bf16_t* __restrict__ gtile, u32x4 (&gv)[4]) {
    const int c = lane & 31, h = lane >> 5;
    const int q4 = (lane & 15) >> 2, p4 = lane & 3, g2 = (lane >> 4) & 1;
    LAS unsigned char* trb = vl + (4 * h + q4) * VROWB + 32 * g2 + 8 * p4;
    const int vr = lane >> 3, vc = lane & 7;
    LAS unsigned char* vw = vl + vr * VROWB + vc * 16;
    LAS unsigned char* kw = vl + ST_K + vr * KROWB + vc * 16;
    LAS unsigned char* krd = vl + ST_K + c * KROWB + 16 * h;
    u32x4 kreg[PD][4]; u32x4 vreg[PD][4];
    const long tstep = (long)32 * dil * ld, istep = (long)8 * dil * ld;
    const bf16_t* kp = kb + ((long)(res + dil * (kidx0 + vr)) * ld + vc * 8);
    const bf16_t* vp = vb + ((long)(res + dil * (kidx0 + vr)) * ld + vc * 8);
#define LOAD_TILE(kt, sl) do { \
        _Pragma("unroll") for (int i = 0; i < 4; ++i) { \
            kreg[sl][i] = *(const u32x4*)(kp + (kt) * tstep + i * istep); vreg[sl][i] = *(const u32x4*)(vp + (kt) * tstep + i * istep); } } while (0)
#pragma unroll
    for (int t = 0; t < PD; ++t) if (t < NKT) LOAD_TILE(t, t);
    bf16x8 qf[4];
#pragma unroll
    for (int kk = 0; kk < 4; ++kk) qf[kk] = *(const bf16x8*)(qrow + 16 * kk + 8 * h);
    if (gtile) {
#pragma unroll
        for (int i = 0; i < 4; ++i) gv[i] = *(const u32x4*)(gtile + (size_t)(vr + 8 * i) * 64 + vc * 8);
    }
    asm volatile("" ::: "memory");
#pragma unroll 1
    for (int kt0 = 0; kt0 < NKT; kt0 += PD) {
#pragma unroll
      for (int sl = 0; sl < PD; ++sl) {
        const int kt = kt0 + sl;
        if (kt < NKT) {
#pragma unroll
        for (int i = 0; i < 4; ++i) { *(LAS u32x4*)(kw + i * 8 * KROWB) = kreg[sl][i]; *(LAS u32x4*)(vw + i * 8 * VROWB) = vreg[sl][i]; }
        f32x16 s;
#pragma unroll
        for (int r = 0; r < 16; ++r) s[r] = 0.f;
#pragma unroll
        for (int kk = 0; kk < 4; ++kk) { const bf16x8 kfr = *(LAS bf16x8*)(krd + 32 * kk); s = MFMA32(kfr, qf[kk], s); }
        asm volatile("" ::: "memory");
        if (kt + PD < NKT) { LOAD_TILE(kt + PD, sl); }
        asm volatile("" ::: "memory");
        if (MODE != 2 && (kt == 0 || kt == NKT - 1)) {
            const int nkb = kidx0 + 32 * kt;
#pragma unroll
            for (int r = 0; r < 16; ++r) { const int nk = nkb + crow(r, h), dist = nq - nk; s[r] = (nk >= 0 && dist >= 0 && dist <= maxd) ? s[r] : -INFINITY; }
        } else if (MODE != 2) {
            const int nkb = kidx0 + 32 * kt;
            if (nkb < 0) {
#pragma unroll
                for (int r = 0; r < 16; ++r) { const int nk = nkb + crow(r, h); s[r] = nk >= 0 ? s[r] : -INFINITY; }
            }
        }
        float mx = s[0];
#pragma unroll
        for (int r = 1; r < 16; ++r) mx = fmaxf(mx, s[r]);
        mx = xhalf_max(mx);
        if (__builtin_amdgcn_ballot_w64(mx > m + 8.0f) != 0ull) {
            const float mnew = fmaxf(m, mx);
            const float alpha = mnew == -INFINITY ? 1.0f : __builtin_amdgcn_exp2f(m - mnew);
            l *= alpha; o0 *= alpha; o1 *= alpha; m = mnew;
        }
        const float mref = m == -INFINITY ? 0.f : m;
        float rs = 0.f;
#pragma unroll
        for (int r = 0; r < 16; ++r) { s[r] = __builtin_amdgcn_exp2f(s[r] - mref); rs += s[r]; }
        l += rs;
        bf16x8 pf[2];
#pragma unroll
        for (int s2 = 0; s2 < 2; ++s2) { u32x4 w; w.x = pack2(s[8 * s2], s[8 * s2 + 1]); w.y = pack2(s[8 * s2 + 2], s[8 * s2 + 3]); w.z = pack2(s[8 * s2 + 4], s[8 * s2 + 5]); w.w = pack2(s[8 * s2 + 6], s[8 * s2 + 7]);
            pf[s2] = __builtin_bit_cast(bf16x8, w); }
#pragma unroll
        for (int s2 = 0; s2 < 2; ++s2) {
            const s16x4 a0 = __builtin_amdgcn_ds_read_tr16_b64_v4i16((LAS s16x4*)(trb + (16 * s2) * VROWB));
            const s16x4 a1 = __builtin_amdgcn_ds_read_tr16_b64_v4i16((LAS s16x4*)(trb + (16 * s2 + 8) * VROWB));
            const s16x4 b0 = __builtin_amdgcn_ds_read_tr16_b64_v4i16((LAS s16x4*)(trb + (16 * s2) * VROWB + 64));
            const s16x4 b1 = __builtin_amdgcn_ds_read_tr16_b64_v4i16((LAS s16x4*)(trb + (16 * s2 + 8) * VROWB + 64));
            const bf16x8 va = __builtin_shufflevector(a0, a1, 0, 1, 2, 3, 4, 5, 6, 7), vbv = __builtin_shufflevector(b0, b1, 0, 1, 2, 3, 4, 5, 6, 7);
            o0 = MFMA32(va, pf[s2], o0);
            o1 = MFMA32(vbv, pf[s2], o1);
        }
        }
      }
    }
#undef LOAD_TILE
}

template <int NKT>
__device__ __forceinline__ void attn_core_img(const bf16_t* __restrict__ qrow, LAS unsigned char* kimg, LAS unsigned char* vimg, float& m, float& l, f32x16& o0, f32x16& o1, const int lane, const bf16_t* __restrict__ gtile, u32x4 (&gv)[4]) {
    const int c = lane & 31, h = lane >> 5;
    const int q4 = (lane & 15) >> 2, p4 = lane & 3, g2 = (lane >> 4) & 1;
    LAS unsigned char* trb = vimg + (4 * h + q4) * VROWB + 32 * g2 + 8 * p4;
    LAS unsigned char* krd = kimg + c * KROWB + 16 * h;
    bf16x8 qf[4];
#pragma unroll
    for (int kk = 0; kk < 4; ++kk) qf[kk] = *(const bf16x8*)(qrow + 16 * kk + 8 * h);
    {
        const int vr = lane >> 3, vc = lane & 7;
#pragma unroll
        for (int i = 0; i < 4; ++i) gv[i] = *(const u32x4*)(gtile + (size_t)(vr + 8 * i) * 64 + vc * 8);
    }
#pragma unroll 1
    for (int kt = 0; kt < NKT; ++kt) {
        f32x16 s;
#pragma unroll
        for (int r = 0; r < 16; ++r) s[r] = 0.f;
#pragma unroll
        for (int kk = 0; kk < 4; ++kk) { const bf16x8 kfr = *(LAS bf16x8*)(krd + kt * 32 * KROWB + 32 * kk); s = MFMA32(kfr, qf[kk], s); }
        float mx = s[0];
#pragma unroll
        for (int r = 1; r < 16; ++r) mx = fmaxf(mx, s[r]);
        mx = xhalf_max(mx);
        if (__builtin_amdgcn_ballot_w64(mx > m + 8.0f) != 0ull) {
            const float mnew = fmaxf(m, mx);
            const float alpha = mnew == -INFINITY ? 1.0f : __builtin_amdgcn_exp2f(m - mnew);
            l *= alpha; o0 *= alpha; o1 *= alpha; m = mnew;
        }
        const float mref = m == -INFINITY ? 0.f : m;
        float rs = 0.f;
#pragma unroll
        for (int r = 0; r < 16; ++r) { s[r] = __builtin_amdgcn_exp2f(s[r] - mref); rs += s[r]; }
        l += rs;
        bf16x8 pf[2];
#pragma unroll
        for (int s2 = 0; s2 < 2; ++s2) { u32x4 w; w.x = pack2(s[8 * s2], s[8 * s2 + 1]); w.y = pack2(s[8 * s2 + 2], s[8 * s2 + 3]); w.z = pack2(s[8 * s2 + 4], s[8 * s2 + 5]); w.w = pack2(s[8 * s2 + 6], s[8 * s2 + 7]);
            pf[s2] = __builtin_bit_cast(bf16x8, w); }
        LAS unsigned char* tb = trb + kt * 32 * VROWB;
#pragma unroll
        for (int s2 = 0; s2 < 2; ++s2) {
            const s16x4 a0 = __builtin_amdgcn_ds_read_tr16_b64_v4i16((LAS s16x4*)(tb + (16 * s2) * VROWB));
            const s16x4 a1 = __builtin_amdgcn_ds_read_tr16_b64_v4i16((LAS s16x4*)(tb + (16 * s2 + 8) * VROWB));
            const s16x4 b0 = __builtin_amdgcn_ds_read_tr16_b64_v4i16((LAS s16x4*)(tb + (16 * s2) * VROWB + 64));
            const s16x4 b1 = __builtin_amdgcn_ds_read_tr16_b64_v4i16((LAS s16x4*)(tb + (16 * s2 + 8) * VROWB + 64));
            const bf16x8 va = __builtin_shufflevector(a0, a1, 0, 1, 2, 3, 4, 5, 6, 7), vbv = __builtin_shufflevector(b0, b1, 0, 1, 2, 3, 4, 5, 6, 7);
            o0 = MFMA32(va, pf[s2], o0);
            o1 = MFMA32(vbv, pf[s2], o1);
        }
    }
}

__device__ __forceinline__ float silu(float g) { return g * __builtin_amdgcn_rcpf(1.0f + __expf(-g)); }
__device__ __forceinline__ void attn_finalize(const f32x16& o0, const f32x16& o1, float l, const u32x4 (&gv)[4], bf16_t* __restrict__ ytile, LAS unsigned char* vl, int lane) {
    const int c = lane & 31, h = lane >> 5, vr = lane >> 3, vc = lane & 7;
    const float inv = __builtin_amdgcn_rcpf(l);
#pragma unroll
    for (int cc = 0; cc < 2; ++cc)
#pragma unroll
        for (int g = 0; g < 4; ++g) {
            const f32x16& o = cc ? o1 : o0;
            u32x2 w; w.x = pack2(o[4 * g] * inv, o[4 * g + 1] * inv); w.y = pack2(o[4 * g + 2] * inv, o[4 * g + 3] * inv);
            *(LAS u32x2*)(vl + c * 136 + (32 * cc + 8 * g + 4 * h) * 2) = w;
        }
#pragma unroll
    for (int i = 0; i < 4; ++i) {
        const int r = vr + 8 * i;
        const u32x2 lo = *(LAS u32x2*)(vl + r * 136 + vc * 16), hi = *(LAS u32x2*)(vl + r * 136 + vc * 16 + 8);
        const unsigned ov[4] = {lo.x, lo.y, hi.x, hi.y};
        u32x4 w;
#pragma unroll
        for (int j = 0; j < 4; ++j) { const float y0 = bflo(ov[j]) * bflo(gv[i][j]), y1 = bfhi(ov[j]) * bfhi(gv[i][j]); w[j] = pack2(y0, y1); }
        *(u32x4*)(ytile + (size_t)r * DM + vc * 8) = w;
    }
}

__device__ __forceinline__ void phase_attn(const Params& p, LAS unsigned char* lds, int rep, int item_lo, int item_hi, unsigned xcc) {
    const bf16_t* proj = (const bf16_t*)(p.ws + OFF_PROJ); const bf16_t* mkv = (const bf16_t*)(p.ws + OFF_MKV); bf16_t* Y = (bf16_t*)(p.ws + OFF_Y);
    unsigned* ctr = (unsigned*)(p.ws + OFF_CTR) + rep * 8;
    const int tid = threadIdx.x, lane = tid & 63, wid = tid >> 6, c = lane & 31, h = lane >> 5;
    LAS unsigned char* vl = lds + ST_V + wid * ST_VW;
    LAS int* item_s = (LAS int*)(lds + ST_ITEM);
    unsigned* memflag = (unsigned*)(p.ws + OFF_CNT) + 192;
    if (rep == 0 && blockIdx.x < 8) {
        pg8::Gemm g; g.A = (const bf16_t*)(p.ws + OFF_U); g.Bt = (const bf16_t*)(p.ws + OFF_WINT); g.M = NTOK; g.N = DIN; g.K = DM;
        MemUnit S; S.L = (int)blockIdx.x;
        EpiIn E; E.proj = (bf16_t*)(p.ws + OFF_PROJ); E.mkv = (bf16_t*)(p.ws + OFF_MKV); E.rope = (const float*)(p.ws + OFF_ROPE);
        pg8::gemm_phase<EpiIn, MemUnit, false>(lds, g, S, E, nullptr);
        asm volatile("s_waitcnt vmcnt(0)" ::: "memory");
        __syncthreads();
        if (tid == 0) { __threadfence(); __hip_atomic_fetch_add(memflag, 1u, __ATOMIC_RELAXED, __HIP_MEMORY_SCOPE_AGENT); }
    }
    unsigned* qctr = (unsigned*)(p.ws + OFF_QCTR) + rep * 8 * 64;
    int dq = 0;
    for (int itn = 0;; ++itn) {
        if (tid == 0) {
            int code = -1;
            while (dq < 8) {
                const int q_ = (int)((xcc + (unsigned)dq) & 7u);
                if (__hip_atomic_load(qctr + q_ * 64, __ATOMIC_RELAXED, __HIP_MEMORY_SCOPE_AGENT) < 128u) {
                    const int j_ = (int)atomicAdd(qctr + q_ * 64, 1u);
                    if (j_ < 128) { code = q_ * 128 + j_; break; }
                }
                ++dq;
            }
            item_s[itn & 1] = code;
        }
        __syncthreads();
        const int code = __builtin_amdgcn_readfirstlane(item_s[itn & 1]);
        if (code < 0) break;
        const int qi = code >> 7, j = code & 127;
        int item;
        if (j < 48) { const int pair = qi + 8 * (j >> 4), b_ = pair / 6, hd = pair - b_ * 6; item = (b_ * 16 + (j & 15)) * 6 + hd; }
        else if (j < 96) { const int jj = j - 48, b_ = qi >> 1, kvh_ = qi & 1, stl = jj / 3, g_ = jj - stl * 3; item = 640 + (b_ * 16 + stl) * 6 + kvh_ * 3 + g_; }
        else { const int jj = j - 96, pair = qi + 8 * (jj >> 4), b_ = pair >> 2, hd = pair & 3; item = 384 + (b_ * 16 + (jj & 15)) * 4 + hd; }
        if (item < item_lo || item >= item_hi) continue;
        if (wid >= 4) __builtin_amdgcn_s_sleep(12);
        if (item < 384) {
            const int st = item / 6, head = item - st * 6, b = st >> 4, t0 = (st & 15) * 512;
            const size_t hb = (size_t)b * SEQ * 64;
            const bf16_t* qh_ = proj + (size_t)(16 + head) * NTOK * 64 + hb; const bf16_t* kh_ = proj + (size_t)(22 + head) * NTOK * 64 + hb;
            const bf16_t* vh_ = proj + (size_t)(28 + head) * NTOK * 64 + hb; const bf16_t* gh_ = proj + (size_t)(34 + head) * NTOK * 64 + hb;
#pragma unroll 1
            for (int pass = 0; pass < 3; ++pass) {
                const int dil = pass == 0 ? 16 : (pass == 1 ? 4 : 1);
#pragma unroll 1
                for (int su = wid; su < 16; su += 8) {
                    int res, n0;
                    if (pass == 0) { res = su; n0 = t0 >> 4; } else if (pass == 1) { res = su & 3; n0 = (t0 >> 2) + 32 * (su >> 2); } else { res = 0; n0 = t0 + 32 * su; }
                    const int nq = n0 + c, posq = res + dil * nq, tokl = posq - t0, rowp = tokl ^ ((tokl >> 4) & 15);
                    LAS unsigned char* so = lds + rowp * ST_ROWB + 8 * h;
                    LAS float* sml = (LAS float*)(lds + ST_ML + rowp * 8);
                    float m, l; f32x16 o0, o1;
                    if (pass == 0) { m = -INFINITY; l = 0.f;
#pragma unroll
                        for (int r = 0; r < 16; ++r) { o0[r] = 0.f; o1[r] = 0.f; }
                    } else {
                        m = sml[0]; l = h == 0 ? sml[1] : 0.f;
#pragma unroll
                        for (int g = 0; g < 4; ++g) {
                            const u32x2 a = *(LAS u32x2*)(so + 16 * g), bb = *(LAS u32x2*)(so + 64 + 16 * g);
                            o0[4 * g] = bflo(a.x); o0[4 * g + 1] = bfhi(a.x); o0[4 * g + 2] = bflo(a.y); o0[4 * g + 3] = bfhi(a.y);
                            o1[4 * g] = bflo(bb.x); o1[4 * g + 1] = bfhi(bb.x); o1[4 * g + 2] = bflo(bb.y); o1[4 * g + 3] = bfhi(bb.y);
                        }
                    }
                    u32x4 gv[4];
                    attn_core<1, 5>(qh_ + (size_t)posq * 64, kh_, vh_, 64, res, dil, n0 - 128, nq, 128, m, l, o0, o1, vl, lane, pass == 2 ? gh_ + (size_t)n0 * 64 : nullptr, gv);
                    l = xhalf_sum(l);
                    if (pass < 2) {
                        if (h == 0) { sml[0] = m; sml[1] = l; }
#pragma unroll
                        for (int g = 0; g < 4; ++g) {
                            u32x2 a, bb; a.x = pack2(o0[4 * g], o0[4 * g + 1]); a.y = pack2(o0[4 * g + 2], o0[4 * g + 3]); bb.x = pack2(o1[4 * g], o1[4 * g + 1]); bb.y = pack2(o1[4 * g + 2], o1[4 * g + 3]);
                            *(LAS u32x2*)(so + 16 * g) = a; *(LAS u32x2*)(so + 64 + 16 * g) = bb;
                        }
                    } else {
                        attn_finalize(o0, o1, l, gv, Y + ((size_t)b * SEQ + n0) * DM + 384 + head * 64, vl, lane);
                    }
                }
                if (pass < 2) __syncthreads();
            }
        } else if (item < 640) {
            const int idx = item - 384, st = idx >> 2, head = idx & 3, b = st >> 4, t0 = (st & 15) * 512;
            if (tid == 0) { unsigned sp = 0; while (__hip_atomic_load(memflag, __ATOMIC_RELAXED, __HIP_MEMORY_SCOPE_AGENT) < 8u && ++sp < (1u << 22)) __builtin_amdgcn_s_sleep(2); }
            __syncthreads();
            __builtin_amdgcn_fence(__ATOMIC_ACQUIRE, "agent");
            const bf16_t* kb = mkv + (size_t)b * 256 * 512 + head * 64;
            LAS unsigned char* kimg = lds + ST_V; LAS unsigned char* vimg = lds + ST_V + 256 * KROWB;
            {
                u32x4 kk_[4], vv_[4];
#pragma unroll
                for (int i = 0; i < 4; ++i) { const int ch = tid + 512 * i, row = ch >> 3, vc_ = ch & 7;
                    kk_[i] = *(const u32x4*)(kb + (size_t)row * 512 + vc_ * 8); vv_[i] = *(const u32x4*)(kb + 256 + (size_t)row * 512 + vc_ * 8); }
#pragma unroll
                for (int i = 0; i < 4; ++i) { const int ch = tid + 512 * i, row = ch >> 3, vc_ = ch & 7;
                    *(LAS u32x4*)(kimg + row * KROWB + vc_ * 16) = kk_[i]; *(LAS u32x4*)(vimg + row * VROWB + vc_ * 16) = vv_[i]; }
            }
            __syncthreads();
            LAS unsigned char* vfin = lds + wid * 4608;
#pragma unroll 1
            for (int su = wid; su < 16; su += 8) {
                const size_t row0 = (size_t)b * SEQ + t0 + 32 * su;
                float m = -INFINITY, l = 0.f; f32x16 o0, o1;
#pragma unroll
                for (int r = 0; r < 16; ++r) { o0[r] = 0.f; o1[r] = 0.f; }
                u32x4 gv[4];
                attn_core_img<8>(proj + ((size_t)(40 + head) * NTOK + row0 + c) * 64, kimg, vimg, m, l, o0, o1, lane, proj + ((size_t)(44 + head) * NTOK + row0) * 64, gv);
                l = xhalf_sum(l);
                attn_finalize(o0, o1, l, gv, Y + row0 * DM + 768 + head * 64, vfin, lane);
            }
        } else {
            const int idx = item - 640, st = idx / 6, qh = idx - st * 6, kvh = qh / 3, b = st >> 4, t0 = (st & 15) * 512;
            const size_t hb = (size_t)b * SEQ * 64;
            const bf16_t* qh_ = proj + (size_t)qh * NTOK * 64 + hb; const bf16_t* kh_ = proj + (size_t)(6 + kvh) * NTOK * 64 + hb;
            const bf16_t* vh_ = proj + (size_t)(8 + kvh) * NTOK * 64 + hb; const bf16_t* gh_ = proj + (size_t)(10 + qh) * NTOK * 64 + hb;
            const float sink = p.sink[qh] * 1.4426950408889634f;
#pragma unroll 1
            for (int su = wid; su < 16; su += 8) {
                const int n0 = t0 + 32 * su, nq = n0 + c;
                float m = sink, l = h == 0 ? 1.0f : 0.f; f32x16 o0, o1;
#pragma unroll
                for (int r = 0; r < 16; ++r) { o0[r] = 0.f; o1[r] = 0.f; }
                u32x4 gv[4];
                attn_core<0, 5>(qh_ + (size_t)nq * 64, kh_, vh_, 64, 0, 1, n0 - 128, nq, 127, m, l, o0, o1, vl, lane, gh_ + (size_t)n0 * 64, gv);
                l = xhalf_sum(l);
                attn_finalize(o0, o1, l, gv, Y + ((size_t)b * SEQ + n0) * DM + qh * 64, vl, lane);
            }
        }
    }
}

__device__ __forceinline__ void phase_post(const Params& p) {
    const int tid = threadIdx.x, lane = tid & 63, wid = tid >> 6, gw = blockIdx.x * 8 + wid, nw = gridDim.x * 8;
    const float* Z = (const float*)(p.ws + OFF_Z);
    for (int row = gw; row < NTOK; row += 2 * nw) {
        const int row2 = row + nw < NTOK ? row + nw : row;
        f32x4 v[4], w2[4], xa[4], xb2[4];
#pragma unroll
        for (int i = 0; i < 4; ++i) { v[i] = *(const f32x4*)(Z + (size_t)row * DM + i * 256 + lane * 4); w2[i] = *(const f32x4*)(Z + (size_t)row2 * DM + i * 256 + lane * 4);
                                      xa[i] = *(const f32x4*)(p.x + (size_t)row * DM + i * 256 + lane * 4); xb2[i] = *(const f32x4*)(p.x + (size_t)row2 * DM + i * 256 + lane * 4); }
        float ss = 0.f, ss2 = 0.f;
#pragma unroll
        for (int i = 0; i < 4; ++i) { ss += v[i][0] * v[i][0] + v[i][1] * v[i][1] + v[i][2] * v[i][2] + v[i][3] * v[i][3];
                                      ss2 += w2[i][0] * w2[i][0] + w2[i][1] * w2[i][1] + w2[i][2] * w2[i][2] + w2[i][3] * w2[i][3]; }
        ss = wave_sum(ss); ss2 = wave_sum(ss2);
        const float r = rsqrtf(ss * (1.0f / 1024.0f) + 1e-6f), r2 = rsqrtf(ss2 * (1.0f / 1024.0f) + 1e-6f);
#pragma unroll
        for (int i = 0; i < 4; ++i) {
            const f32x4 gg = *(const f32x4*)(p.post_g + i * 256 + lane * 4);
            *(f32x4*)(p.out + (size_t)row * DM + i * 256 + lane * 4) = xa[i] + v[i] * r * gg;
            *(f32x4*)(p.out + (size_t)row2 * DM + i * 256 + lane * 4) = xb2[i] + w2[i] * r2 * gg;
        }
    }
}


#define XB_TMO      128
#define XB_XCNT(j)  (256  + 64 * (j))
#define XB_XSUB(j)  (1280 + 64 * (j))
#define XB_XGEN(j)  (2304 + 64 * (j))
#define XB_TOP      3328
#define XB_TOPGEN   3392
#define XCD_BAR_WORDS 3456
#define XB_SPIN_CAP (1u << 18)

__device__ __forceinline__ unsigned xb_ld(unsigned* p)              { return __hip_atomic_load(p, __ATOMIC_RELAXED, __HIP_MEMORY_SCOPE_AGENT); }
__device__ __forceinline__ unsigned xb_add(unsigned* p, unsigned v) { return __hip_atomic_fetch_add(p, v, __ATOMIC_RELAXED, __HIP_MEMORY_SCOPE_AGENT); }
__device__ __forceinline__ unsigned xb_xcc_id() { return (unsigned)__builtin_amdgcn_s_getreg((3 << 11) | 20) & 0xFu; }
#define XB_SPIN(cond, bar) do { unsigned _sp = 0; while (cond) { __builtin_amdgcn_s_sleep(1); \
    if ((++_sp & 255u) == 0u) { if (xb_ld(&(bar)[XB_TMO])) break; if (_sp > XB_SPIN_CAP) { atomicAdd(&(bar)[XB_TMO], 1u); break; } } } } while (0)

struct XcdBarrier {
    unsigned* bar; unsigned x;
    volatile LAS unsigned* st;
};

__device__ __forceinline__ XcdBarrier xcd_barrier_post(unsigned* bar, volatile LAS unsigned* st) {
    XcdBarrier b; b.bar = bar; b.x = xb_xcc_id(); b.st = st;
    if (threadIdx.x == 0) (void)xb_add(&bar[XB_XCNT(b.x)], 1u);
    return b;
}
__device__ __forceinline__ void xcd_barrier_complete(unsigned* bar, unsigned x, unsigned& nloc, unsigned& nx) {
    const unsigned G = gridDim.x * gridDim.y * gridDim.z;
    unsigned sum, cnt, mine, sp = 0u;
    for (;;) {
        sum = 0u; cnt = 0u; mine = 0u;
#pragma unroll
        for (unsigned j = 0; j < 16; ++j) { const unsigned c = xb_ld(&bar[XB_XCNT(j)]); sum += c; cnt += (c > 0u) ? 1u : 0u; mine = (j == x) ? c : mine; }
        if (sum == G) break;
        __builtin_amdgcn_s_sleep(1);
        if ((++sp & 255u) == 0u) { if (xb_ld(&bar[XB_TMO])) break; if (sp > XB_SPIN_CAP) { atomicAdd(&bar[XB_TMO], 1u); break; } }
    }
    nloc = mine > 0u ? mine : 1u; nx = cnt > 0u ? cnt : 1u;
}

__device__ __forceinline__ void xcd_barrier(const XcdBarrier& b) {
    asm volatile("s_waitcnt vmcnt(0)" ::: "memory");
    __syncthreads();
    if (threadIdx.x == 0) {
        unsigned* bar = b.bar;
        __builtin_amdgcn_s_waitcnt(0);
        unsigned nloc = b.st[0], nx = b.st[1];
        if (nloc == 0u) { xcd_barrier_complete(bar, b.x, nloc, nx); b.st[0] = nloc; b.st[1] = nx; }
        const unsigned old = xb_add(&bar[XB_XSUB(b.x)], 1u);
        const unsigned gen = old / nloc;
        if (old + 1u == (gen + 1u) * nloc) {
            __builtin_amdgcn_fence(__ATOMIC_RELEASE, "agent");
            asm volatile("s_waitcnt vmcnt(0)" ::: "memory");
            const unsigned og = xb_add(&bar[XB_TOP], 1u);
            const unsigned tg = og / nx;
            if (og + 1u == (tg + 1u) * nx) xb_add(&bar[XB_TOPGEN], 1u);
            else XB_SPIN(xb_ld(&bar[XB_TOPGEN]) == tg, bar);
            __builtin_amdgcn_fence(__ATOMIC_ACQUIRE, "agent");
            xb_add(&bar[XB_XGEN(b.x)], 1u);
            asm volatile("s_waitcnt vmcnt(0)" ::: "memory");
        } else {
            XB_SPIN(xb_ld(&bar[XB_XGEN(b.x)]) == gen, bar);
            __builtin_amdgcn_fence(__ATOMIC_ACQUIRE, "agent");
            asm volatile("s_waitcnt vmcnt(0)" ::: "memory");
        }
    }
    __syncthreads();
}

__global__ __launch_bounds__(512, 2) void fwd_kernel(Params p) {
    extern __shared__ __attribute__((aligned(16))) unsigned char smem[];
    cg::grid_group grid = cg::this_grid();
    LAS unsigned char* lds = (LAS unsigned char*)smem;
    if (threadIdx.x < 4) ((LAS unsigned*)(lds + ST_XB))[threadIdx.x] = 0u;
    __syncthreads();
    const XcdBarrier xb = xcd_barrier_post((unsigned*)(p.ws + OFF_BAR), (volatile LAS unsigned*)(lds + ST_XB));
    if (p.out == nullptr) grid.sync();
#define GSYNC() xcd_barrier(xb)
#define GIN_BLOCK { \
        pg8::Gemm g; g.A = (const bf16_t*)(p.ws + OFF_U); g.Bt = (const bf16_t*)(p.ws + OFF_WINT); g.M = NTOK; g.N = DIN; g.K = DM; \
        pg8::StaticOrder S; S.init(NTOK, DIN, (int)gridDim.x, (int)blockIdx.x); \
        EpiIn E; E.proj = (bf16_t*)(p.ws + OFF_PROJ); E.mkv = (bf16_t*)(p.ws + OFF_MKV); E.rope = (const float*)(p.ws + OFF_ROPE); \
        pg8::gemm_phase<EpiIn, pg8::StaticOrder, false>(lds, g, S, E, nullptr); \
        GSYNC(); }
#define GOUT_BLOCK { \
        pg8::Gemm g; g.A = (const bf16_t*)(p.ws + OFF_Y); g.Bt = (const bf16_t*)(p.ws + OFF_WOUTT); g.M = NTOK; g.N = DM; g.K = DM; \
        OneUnit S; S.so.init(NTOK, DM, (int)gridDim.x, (int)blockIdx.x); \
        EpiOutFused E; E.x = p.x; E.g = p.post_g; E.out = p.out; E.part = (float*)(p.ws + OFF_PART); E.cnt = (unsigned*)(p.ws + OFF_CNT); \
        S.round = 0; pg8::gemm_phase<EpiOutFused, OneUnit, false>(lds, g, S, E, nullptr); \
        S.round = 1; pg8::gemm_phase<EpiOutFused, OneUnit, false>(lds, g, S, E, nullptr); }
    phase_prep(p); GSYNC();
#ifdef REP_SYNC
    GSYNC(); GSYNC(); GSYNC(); GSYNC(); GSYNC(); GSYNC(); GSYNC(); GSYNC();
#endif
#ifdef REP_PREP
    phase_prep(p); GSYNC();
#endif
    GIN_BLOCK
#if REP_GIN > 1
    GIN_BLOCK
#endif
    phase_attn(p, lds, 0, 0, 1024, xb.x); GSYNC();
#if REP_ATTN > 1
    phase_attn(p, lds, 1, REP_LO, REP_HI, xb.x); GSYNC();
#endif
    GOUT_BLOCK
#ifdef REP_GOUT
    if (gridDim.x == 256u) GOUT_BLOCK
    else {
        pg8::Gemm g; g.A = (const bf16_t*)(p.ws + OFF_Y); g.Bt = (const bf16_t*)(p.ws + OFF_WOUTT); g.M = NTOK; g.N = DM; g.K = DM;
        pg8::StaticOrder S; S.init(NTOK, DM, (int)gridDim.x, (int)blockIdx.x);
        pg8::EpiF32 E; E.C = (float*)(p.ws + OFF_Z); E.ldc = DM; E.bias = nullptr;
        pg8::gemm_phase<pg8::EpiF32, pg8::StaticOrder, false>(lds, g, S, E, nullptr);
        GSYNC();
        phase_post(p);
    }
#endif
}

extern "C" void kernel_launch(void* const* d_in, const int* in_sizes, int n_in, void* d_out, int out_size, void* d_ws, size_t ws_size, hipStream_t stream) {
    static int grid_blocks = 0;
    if (!grid_blocks) {
        int dev = 0, cus = 0, per_cu = 0;
        hipGetDevice(&dev);
        hipDeviceGetAttribute(&cus, hipDeviceAttributeMultiprocessorCount, dev);
        hipFuncSetAttribute((const void*)fwd_kernel, hipFuncAttributeMaxDynamicSharedMemorySize, LDS_BYTES);
        hipOccupancyMaxActiveBlocksPerMultiprocessor(&per_cu, (const void*)fwd_kernel, 512, LDS_BYTES);
        if (per_cu < 1) { fprintf(stderr, "occupancy query returned %d\n", per_cu); per_cu = 1; }
        grid_blocks = cus * per_cu;
    }
    Params p{};
    p.x = (const float*)d_in[0]; p.mem = (const float*)d_in[1]; p.pre_g = (const float*)d_in[2]; p.w_in = (const float*)d_in[3]; p.sink = (const float*)d_in[4];
    p.mem_g = (const float*)d_in[5]; p.w_memkv = (const float*)d_in[6]; p.w_out = (const float*)d_in[7]; p.post_g = (const float*)d_in[8];
    p.out = (float*)d_out; p.ws = (unsigned char*)d_ws;
    void* args[] = {&p};
    hipMemsetAsync((unsigned char*)d_ws + OFF_BAR, 0, 16384 + 8192, stream);
    hipError_t e = hipLaunchCooperativeKernel((const void*)fwd_kernel, dim3(grid_blocks), dim3(512), args, LDS_BYTES, stream);
    if (e != hipSuccess) fprintf(stderr, "cooperative launch failed: %s (grid %d)\n", hipGetErrorString(e), grid_blocks);
}
```

```cpp
#include <hip/hip_runtime.h>
#include <hip/hip_cooperative_groups.h>
#include <cstdio>
namespace cg = cooperative_groups;
namespace pg8 {
#define PG8_LAS __attribute__((address_space(3)))
typedef unsigned short bf16_t;
typedef short bf16x8 __attribute__((ext_vector_type(8)));
typedef float f32x4 __attribute__((ext_vector_type(4)));
typedef unsigned u32x4 __attribute__((ext_vector_type(4)));
constexpr int BM = 256, BK = 64, HALF = 128, HTB = HALF * BK * 2  , STAGE_BYTES = 8 * HTB, NXCD = 8, WGM = 8;

__host__ __device__ __forceinline__ int lds_byte(int r, int c) { const int st = (r >> 4) * 2 + (c >> 5), rr = r & 15, cc = c & 31, ob = rr * 64 + cc * 2; return st * 1024 + (ob ^ (((ob >> 9) & 1) << 5)); }
__host__ __device__ __forceinline__ void stage_rc(int b, int& R, int& C) { const int st = b / 1024, sb = b % 1024, swz = sb ^ (((sb >> 9) & 1) << 5); R = (st >> 1) * 16 + swz / 64; C = (st & 1) * 32 + (swz % 64) / 2; }
__host__ __device__ __forceinline__ int perm32(int rho) { const int n = rho >> 4, i = rho & 15; return 8 * (i >> 2) + 4 * n + (i & 3); }

struct Unit { int pm, pn; };
struct Gemm { const bf16_t* A; const bf16_t* Bt; int M, N, K; };
struct StaticOrder {
    int nM, nN, nwg, G, c;
    __host__ __device__ void init(int M, int N, int G_, int c_) { nM = M / BM; nN = N / BM; nwg = nM * nN; G = G_; c = c_; }
    __host__ __device__ bool next(int i, Unit& u) const {
        const long L = (long)i * G + c; if (L >= nwg) return false;
        int wgid = (int)L; { const int q = nwg / NXCD, r = nwg % NXCD, xcd = wgid % NXCD, off = wgid / NXCD; wgid = (xcd < r ? xcd * (q + 1) : r * (q + 1) + (xcd - r) * q) + off; }
        const int nig = WGM * nN, gid = wgid / nig, fm = gid * WGM, gsz = (nM - fm) < WGM ? (nM - fm) : WGM;
        u.pm = fm + ((wgid % nig) % gsz); u.pn = (wgid % nig) / gsz; return true;
    }
    __device__ __forceinline__ void a_ready(const Unit&) const {}
    __device__ __forceinline__ void done(const Unit&) const {}
};
__device__ __forceinline__ unsigned cvt_pk_bf16(float lo, float hi) { unsigned r; asm volatile("v_cvt_pk_bf16_f32 %0, %1, %2" : "=v"(r) : "v"(lo), "v"(hi)); return r; }
struct EpiF32 {
    static constexpr bool PERM = false, AFTER_DRAIN = false;
    float* C; int ldc; const float* bias;
    __device__ __forceinline__ void operator()(const f32x4 (&acc)[2][2][4][2], const Unit& u, int wr, int wc, int fr, int fq) const {
        const int row0 = u.pm * BM + wr * 64 + fr, col0 = u.pn * BM + wc * 32 + 4 * fq;
        f32x4 bv[2][2];
#pragma unroll
        for (int bj = 0; bj < 2; ++bj)
#pragma unroll
            for (int n = 0; n < 2; ++n) bv[bj][n] = bias ? *(const f32x4*)(bias + col0 + bj * HALF + n * 16) : (f32x4){0.f, 0.f, 0.f, 0.f};
#pragma unroll
        for (int ai = 0; ai < 2; ++ai)
#pragma unroll
            for (int m = 0; m < 4; ++m) { float* rowp = C + (size_t)(row0 + ai * HALF + m * 16) * ldc + col0;
#pragma unroll
                for (int bj = 0; bj < 2; ++bj)
#pragma unroll
                    for (int n = 0; n < 2; ++n) *(f32x4*)(rowp + bj * HALF + n * 16) = acc[ai][bj][m][n] + bv[bj][n]; }
    }
};
template <class Epi, class Sched, bool STAMP = false>
__device__ __forceinline__ void gemm_phase(PG8_LAS unsigned char* lds, const Gemm g, const Sched& S, const Epi& E, unsigned long long* stamps) {
    const int tid = threadIdx.x, wid = __builtin_amdgcn_readfirstlane(tid >> 6), lane = tid & 63, wr = wid >> 2, wc = wid & 3, fr = lane & 15, fq = lane >> 4;
    const int K = g.K, nt = K / BK;
#define PG8_STAMP() do {} while (0)
    unsigned voffA[2], voffB[2];
#pragma unroll
    for (int i = 0; i < 2; ++i) { int R, C; stage_rc(tid * 16 + i * 8192, R, C); const int Rb = Epi::PERM ? ((R & ~31) + perm32(R & 31)) : R;
        voffA[i] = (unsigned)(R * K + C) * 2u; voffB[i] = (unsigned)(Rb * K + C) * 2u; }
    const size_t kstep = (size_t)(BK * 2);
    const size_t hstep = (size_t)HALF * K * 2;
    const size_t tstep = 2 * hstep;
    const unsigned ldsw = (unsigned)wid * 1024u;
    const int aoff = lds_byte(wr * 64 + fr, fq * 8), boff = lds_byte(wc * 32 + fr, fq * 8);
#define PG8_SA(b, h) (((b) * 2 + (h)) * HTB)
#define PG8_SB(b, h) ((4 + (b) * 2 + (h)) * HTB)
#define PG8_STAGE(bufoff, gbase, voff) do { _Pragma("unroll") for (int _i = 0; _i < 2; ++_i) \
        __builtin_amdgcn_global_load_lds((const unsigned*)((const char*)(gbase) + (voff)[_i]), (PG8_LAS unsigned*)(lds + (bufoff) + ldsw + _i * 8192), 16, 0, 0); } while (0)
#define PG8_LDA(dst, b, h) do { _Pragma("unroll") for (int m = 0; m < 4; ++m) _Pragma("unroll") for (int k = 0; k < 2; ++k) dst[m][k] = *(const PG8_LAS bf16x8*)(lds + PG8_SA(b, h) + aoff + m * 2048 + k * 1024); } while (0)
#define PG8_LDB(dst, b, h) do { _Pragma("unroll") for (int n = 0; n < 2; ++n) _Pragma("unroll") for (int k = 0; k < 2; ++k) dst[n][k] = *(const PG8_LAS bf16x8*)(lds + PG8_SB(b, h) + boff + n * 2048 + k * 1024); } while (0)
#define PG8_MMA(ai, bj, At, Bt) do { __builtin_amdgcn_s_setprio(1); _Pragma("unroll") for (int m = 0; m < 4; ++m) _Pragma("unroll") for (int n = 0; n < 2; ++n) _Pragma("unroll") for (int k = 0; k < 2; ++k) \
        acc[ai][bj][m][n] = __builtin_amdgcn_mfma_f32_16x16x32_bf16(Bt[n][k], At[m][k], acc[ai][bj][m][n], 0, 0, 0); __builtin_amdgcn_s_setprio(0); } while (0)
#define PG8_WAIT_V(n) asm volatile("s_waitcnt vmcnt(" #n ")" ::: "memory")
#define PG8_WAIT_L(n) asm volatile("s_waitcnt lgkmcnt(" #n ")" ::: "memory")
#define PG8_BAR __builtin_amdgcn_s_barrier()
#define PG8_SCHED __builtin_amdgcn_sched_barrier(0)
    Unit cur, nxt; int ui = 0;
    if (!S.next(0, cur)) return;
    f32x4 acc[2][2][4][2];
#pragma unroll
    for (int a = 0; a < 2; ++a)
#pragma unroll
        for (int b = 0; b < 2; ++b)
#pragma unroll
            for (int m = 0; m < 4; ++m)
#pragma unroll
                for (int n = 0; n < 2; ++n) acc[a][b][m][n] = (f32x4){0.f, 0.f, 0.f, 0.f};
    bf16x8 At[4][2], B0[2][2], B1[2][2];
    const char* cA = (const char*)g.A + (size_t)cur.pm * tstep; const char* cB = (const char*)g.Bt + (size_t)cur.pn * tstep;
    S.a_ready(cur);
    PG8_STAGE(PG8_SB(0, 0), cB, voffB); PG8_STAGE(PG8_SA(0, 0), cA, voffA); PG8_STAGE(PG8_SB(0, 1), cB + hstep, voffB); PG8_STAGE(PG8_SA(0, 1), cA + hstep, voffA);
    if (wr == 1) PG8_BAR;
    PG8_WAIT_V(4); PG8_BAR;
    PG8_STAGE(PG8_SB(1, 0), cB + kstep, voffB); PG8_STAGE(PG8_SA(1, 0), cA + kstep, voffA); PG8_STAGE(PG8_SB(1, 1), cB + hstep + kstep, voffB);
    PG8_WAIT_V(6); PG8_BAR;
    PG8_STAMP();
    for (;;) {
        const bool has_next = S.next(ui + 1, nxt);
        const char* nA = has_next ? (const char*)g.A + (size_t)nxt.pm * tstep : cA; const char* nB = has_next ? (const char*)g.Bt + (size_t)nxt.pn * tstep : cB;
        for (int t = 0; t < nt; t += 2) {
            const bool last = (t == nt - 2);
            const char* a1 = cA + (size_t)(t + 1) * kstep;
            const char* a2 = last ? nA : cA + (size_t)(t + 2) * kstep; const char* b2 = last ? nB : cB + (size_t)(t + 2) * kstep;
            const char* a3 = a2 + kstep; const char* b3 = b2 + kstep;
            if (last && has_next) S.a_ready(nxt);
            PG8_LDB(B0, 0, 0); PG8_SCHED; PG8_LDA(At, 0, 0); PG8_STAGE(PG8_SA(1, 1), a1 + hstep, voffA);
            PG8_WAIT_L(8); PG8_BAR; PG8_WAIT_L(0); PG8_MMA(0, 0, At, B0); PG8_BAR; PG8_SCHED;
            PG8_LDB(B1, 0, 1); PG8_STAGE(PG8_SB(0, 0), b2, voffB);
            PG8_BAR; PG8_WAIT_L(0); PG8_MMA(0, 1, At, B1); PG8_BAR;
            PG8_LDA(At, 0, 1); PG8_STAGE(PG8_SA(0, 0), a2, voffA);
            PG8_BAR; PG8_WAIT_L(0); PG8_MMA(1, 0, At, B0); PG8_BAR; PG8_SCHED;
            PG8_STAGE(PG8_SB(0, 1), b2 + hstep, voffB);
            PG8_WAIT_V(6); PG8_BAR; PG8_MMA(1, 1, At, B1); PG8_BAR;
            PG8_LDB(B0, 1, 0); PG8_SCHED; PG8_LDA(At, 1, 0); PG8_STAGE(PG8_SA(0, 1), a2 + hstep, voffA);
            PG8_WAIT_L(8); PG8_BAR; PG8_WAIT_L(0); PG8_MMA(0, 0, At, B0); PG8_BAR; PG8_SCHED;
            PG8_LDB(B1, 1, 1); PG8_STAGE(PG8_SB(1, 0), b3, voffB);
            PG8_BAR; PG8_WAIT_L(0); PG8_MMA(0, 1, At, B1); PG8_BAR;
            PG8_LDA(At, 1, 1); PG8_STAGE(PG8_SA(1, 0), a3, voffA);
            PG8_BAR; PG8_WAIT_L(0); PG8_MMA(1, 0, At, B0); PG8_BAR; PG8_SCHED;
            PG8_STAGE(PG8_SB(1, 1), b3 + hstep, voffB);
            PG8_WAIT_V(6); PG8_BAR; PG8_MMA(1, 1, At, B1); PG8_BAR;
        }
        PG8_STAMP();
        if constexpr (!Epi::AFTER_DRAIN) { E(acc, cur, wr, wc, fr, fq); S.done(cur); }
        PG8_STAMP();
        if (!has_next) break;
#pragma unroll
        for (int a = 0; a < 2; ++a)
#pragma unroll
            for (int b = 0; b < 2; ++b)
#pragma unroll
                for (int m = 0; m < 4; ++m)
#pragma unroll
                    for (int n = 0; n < 2; ++n) acc[a][b][m][n] = (f32x4){0.f, 0.f, 0.f, 0.f};
        cur = nxt; cA = nA; cB = nB; ++ui;
    }
    PG8_WAIT_V(0);
    if (wr == 0) PG8_BAR;
    PG8_BAR;
    if constexpr (Epi::AFTER_DRAIN) { E.fused(acc, cur, wr, wc, fr, fq, lds, wid, lane); S.done(cur); }
    PG8_STAMP();
#undef PG8_STAMP
#undef PG8_SA
#undef PG8_SB
#undef PG8_STAGE
#undef PG8_LDA
#undef PG8_LDB
#undef PG8_MMA
#undef PG8_WAIT_V
#undef PG8_WAIT_L
#undef PG8_BAR
#undef PG8_SCHED
}
}
using pg8::bf16_t; using pg8::bf16x8; using pg8::f32x4; using pg8::u32x4; using pg8::Unit;
#define LAS __attribute__((address_space(3)))
typedef short s16x4 __attribute__((ext_vector_type(4)));
typedef float f32x16 __attribute__((ext_vector_type(16)));
typedef float f32x2 __attribute__((ext_vector_type(2)));
typedef __bf16 bf16x2_t __attribute__((ext_vector_type(2)));
typedef unsigned u32x2 __attribute__((ext_vector_type(2)));

constexpr int NTOK = 32768, SEQ = 8192, DM = 1024, DIN = 3072, MROWS = 32768 + 1024;
constexpr size_t OFF_U = 0, OFF_WINT = 69206016, OFF_WOUTT = 76546048, OFF_ROPE = 78643200, OFF_MKV = 79167488, OFF_CTR = 80216064,
                 OFF_Y = OFF_U  , OFF_PROJ = 147325184, OFF_Z = OFF_PROJ, OFF_BAR = 348651776, OFF_CNT = OFF_BAR + 16384, OFF_QCTR = OFF_CNT + 1024, OFF_PART = OFF_CNT + 8192;
#ifndef REP_ATTN
#define REP_ATTN 1
#endif
#ifndef REP_GIN
#define REP_GIN 1
#endif
#ifndef REP_MISC
#define REP_MISC 1
#endif
constexpr int LDS_BYTES = 159776;
constexpr int ST_ROWB = 136, ST_ML = 69632, ST_V = 73728, ST_VW = 10752, ST_K = 6144, ST_ITEM = 159744, ST_XB = 159760, VROWB = 192, KROWB = 144;

struct Params { const float *x, *mem, *pre_g, *w_in, *sink, *mem_g, *w_memkv, *w_out, *post_g; float* out; unsigned char* ws; };

__device__ __forceinline__ unsigned pack2(float lo, float hi) { f32x2 v; v.x = lo; v.y = hi; return __builtin_bit_cast(unsigned, __builtin_convertvector(v, bf16x2_t)); }
__device__ __forceinline__ float bflo(unsigned w) { return __uint_as_float(w << 16); }
__device__ __forceinline__ float bfhi(unsigned w) { return __uint_as_float(w & 0xffff0000u); }
__device__ __forceinline__ float wave_sum(float v) {
#pragma unroll
    for (int o = 32; o >= 1; o >>= 1) v += __shfl_xor(v, o);
    return v;
}

__device__ __forceinline__ void transpose_tile(const float* __restrict__ W, int N, bf16_t* __restrict__ WT, int task, int lane) {
    const int ntn = N >> 6, k0 = (task / ntn) * 64, n = (task % ntn) * 64 + lane;
    const float* src = W + (size_t)k0 * N + n;
    float v[64];
#pragma unroll
    for (int r = 0; r < 64; ++r) v[r] = __builtin_nontemporal_load(src + (size_t)r * N);
    bf16_t* dst = WT + (size_t)n * 1024 + k0;
#pragma unroll
    for (int q = 0; q < 8; ++q) {
        u32x4 w; w.x = pack2(v[8 * q], v[8 * q + 1]); w.y = pack2(v[8 * q + 2], v[8 * q + 3]); w.z = pack2(v[8 * q + 4], v[8 * q + 5]); w.w = pack2(v[8 * q + 6], v[8 * q + 7]);
        *(u32x4*)(dst + 8 * q) = w;
    }
}
__device__ __forceinline__ void phase_prep(const Params& p) {
    const int tid = threadIdx.x, lane = tid & 63, wid = tid >> 6;
    const int gw = blockIdx.x * 8 + wid, nw = gridDim.x * 8, gt = blockIdx.x * 512 + tid, nt = gridDim.x * 512;
    bf16_t* U = (bf16_t*)(p.ws + OFF_U);
    if (blockIdx.x == 0 && tid < 2) ((unsigned*)(p.ws + OFF_CTR))[tid * 8] = 0u;
    for (int row = gw; row < MROWS; row += 2 * nw) {
        const int row2 = row + nw < MROWS ? row + nw : row;
        const float* src = row < NTOK ? p.x + (size_t)row * DM : p.mem + (size_t)(row - NTOK) * DM;
        const float* src2 = row2 < NTOK ? p.x + (size_t)row2 * DM : p.mem + (size_t)(row2 - NTOK) * DM;
        const float* g = row < NTOK ? p.pre_g : p.mem_g;
        const float* g2 = row2 < NTOK ? p.pre_g : p.mem_g;
        f32x4 v[4], w2[4];
#pragma unroll
        for (int i = 0; i < 4; ++i) { v[i] = __builtin_nontemporal_load((const f32x4*)(src + i * 256 + lane * 4)); w2[i] = __builtin_nontemporal_load((const f32x4*)(src2 + i * 256 + lane * 4)); }
        float ss = 0.f, ss2 = 0.f;
#pragma unroll
        for (int i = 0; i < 4; ++i) { ss += v[i][0] * v[i][0] + v[i][1] * v[i][1] + v[i][2] * v[i][2] + v[i][3] * v[i][3];
                                      ss2 += w2[i][0] * w2[i][0] + w2[i][1] * w2[i][1] + w2[i][2] * w2[i][2] + w2[i][3] * w2[i][3]; }
        ss = wave_sum(ss); ss2 = wave_sum(ss2);
        const float r = rsqrtf(ss * (1.0f / 1024.0f) + 1e-6f), r2 = rsqrtf(ss2 * (1.0f / 1024.0f) + 1e-6f);
#pragma unroll
        for (int i = 0; i < 4; ++i) {
            const f32x4 gg = *(const f32x4*)(g + i * 256 + lane * 4), gg2 = *(const f32x4*)(g2 + i * 256 + lane * 4);
            u32x2 w; w.x = pack2(v[i][0] * r * gg[0], v[i][1] * r * gg[1]); w.y = pack2(v[i][2] * r * gg[2], v[i][3] * r * gg[3]);
            *(u32x2*)(U + (size_t)row * DM + i * 256 + lane * 4) = w;
            u32x2 y; y.x = pack2(w2[i][0] * r2 * gg2[0], w2[i][1] * r2 * gg2[1]); y.y = pack2(w2[i][2] * r2 * gg2[2], w2[i][3] * r2 * gg2[3]);
            *(u32x2*)(U + (size_t)row2 * DM + i * 256 + lane * 4) = y;
        }
    }
    bf16_t* WinT = (bf16_t*)(p.ws + OFF_WINT);
    for (int task = gw; task < 768 + 128 + 256; task += nw) {
        if (task < 768) transpose_tile(p.w_in, 3072, WinT, task, lane);
        else if (task < 896) transpose_tile(p.w_memkv, 512, WinT + (size_t)3072 * 1024, task - 768, lane);
        else transpose_tile(p.w_out, 1024, (bf16_t*)(p.ws + OFF_WOUTT), task - 896, lane);
    }
    float* rope = (float*)(p.ws + OFF_ROPE);
    for (int it = gt; it < SEQ * 8; it += nt) {
        const int pos = it >> 3, i = it & 7;
        const float inv = i == 0 ? 1.0f : i == 1 ? 0x1.8d275ep-3f : i == 2 ? 0x1.341190p-5f : i == 3 ? 0x1.ddee9cp-8f : i == 4 ? 0x1.72ba44p-10f : i == 5 ? 0x1.1f91f0p-12f : i == 6 ? 0x1.be2188p-15f : 0x1.5a0f4ep-17f;
        const float ang = (float)pos * inv;
        rope[pos * 16 + i] = cosf(ang); rope[pos * 16 + 8 + i] = sinf(ang);
    }
}

struct MemUnit {
    int L;
    __device__ bool next(int i, Unit& u) const { if (i != 0) return false; u.pm = 128 + (L >> 1); u.pn = 12 + (L & 1); return true; }
    __device__ __forceinline__ void a_ready(const Unit&) const {}
    __device__ __forceinline__ void done(const Unit&) const {}
};
struct EpiIn {
    static constexpr bool PERM = true, AFTER_DRAIN = false;
    bf16_t* proj; bf16_t* mkv; const float* rope;
    __device__ __forceinline__ void operator()(const f32x4 (&acc)[2][2][4][2], const Unit& u, int wr, int wc, int fr, int fq) const {
        if (u.pm >= 128) {
            const int row0 = (u.pm - 128) * 256 + wr * 64 + fr, col0 = (u.pn - 12) * 256 + wc * 32 + 8 * fq;
#pragma unroll
            for (int ai = 0; ai < 2; ++ai)
#pragma unroll
                for (int m = 0; m < 4; ++m) { bf16_t* rowp = mkv + (size_t)(row0 + ai * 128 + m * 16) * 512 + col0;
#pragma unroll
                    for (int bj = 0; bj < 2; ++bj) { const f32x4 v0 = acc[ai][bj][m][0], v1 = acc[ai][bj][m][1];
                        u32x4 w; w.x = pack2(v0[0], v0[1]); w.y = pack2(v0[2], v0[3]); w.z = pack2(v1[0], v1[1]); w.w = pack2(v1[2], v1[3]);
                        *(u32x4*)(rowp + bj * 128) = w; } }
            return;
        }
        const int row0 = u.pm * 256 + wr * 64 + fr;
        bf16_t* __restrict__ projr = proj; const float* __restrict__ roper = rope;
#pragma unroll
        for (int bj = 0; bj < 2; ++bj) {
            const int cg0 = u.pn * 256 + bj * 128 + wc * 32;
            const float scale = (cg0 < 384 || (cg0 >= 1024 && cg0 < 1408) || (cg0 >= 2560 && cg0 < 2816)) ? 0.18033688011112042f : 1.0f;
            const bool rope_on = (cg0 < 512 || (cg0 >= 1024 && cg0 < 1792)) && ((cg0 & 63) == 0);
            const bool gate_cols = (cg0 >= 640 && cg0 < 1024) || (cg0 >= 2176 && cg0 < 2560) || cg0 >= 2816;
#pragma unroll
            for (int ai = 0; ai < 2; ++ai)
#pragma unroll
                for (int m = 0; m < 4; ++m) {
                    const int row = row0 + ai * 128 + m * 16;
                    f32x4 v0 = acc[ai][bj][m][0], v1 = acc[ai][bj][m][1];
                    if (rope_on) {
                        f32x4 p0, p1;
#pragma unroll
                        for (int j = 0; j < 4; ++j) { p0[j] = __shfl_xor(v0[j], 16); p1[j] = __shfl_xor(v1[j], 16); }
                        if (fq < 2) {
                            const float* cs = roper + (size_t)(row & (SEQ - 1)) * 16;
                            const f32x4 c0 = *(const f32x4*)(cs), c1 = *(const f32x4*)(cs + 4), s0 = *(const f32x4*)(cs + 8), s1 = *(const f32x4*)(cs + 12);
                            const float sg = fq == 0 ? -1.0f : 1.0f;
                            v0 = v0 * c0 + sg * (p0 * s0); v1 = v1 * c1 + sg * (p1 * s1);
                        }
                    }
                    v0 *= scale; v1 *= scale;
                    if (gate_cols) {
#pragma unroll
                        for (int j = 0; j < 4; ++j) { v0[j] = v0[j] * __builtin_amdgcn_rcpf(1.0f + __expf(-v0[j])); v1[j] = v1[j] * __builtin_amdgcn_rcpf(1.0f + __expf(-v1[j])); }
                    }
                    u32x4 w; w.x = pack2(v0[0], v0[1]); w.y = pack2(v0[2], v0[3]); w.z = pack2(v1[0], v1[1]); w.w = pack2(v1[2], v1[3]);
                    *(u32x4*)(projr + ((size_t)(cg0 >> 6) * NTOK + row) * 64 + (cg0 & 63) + 8 * fq) = w;
                }
        }
    }
};

struct OneUnit {
    pg8::StaticOrder so; int round;
    __device__ bool next(int i, Unit& u) const { return i == 0 ? so.next(round, u) : false; }
    __device__ __forceinline__ void a_ready(const Unit&) const {}
    __device__ __forceinline__ void done(const Unit&) const {}
};
struct EpiOutFused {
    static constexpr bool PERM = false, AFTER_DRAIN = true;
    const float* x; const float* g; float* out; float* part; unsigned* cnt;
    __device__ __forceinline__ void fused(const f32x4 (&acc)[2][2][4][2], const Unit& u, int wr, int wc, int fr, int fq, LAS unsigned char*, int, int) const {
        const int row0 = u.pm * 256 + wr * 64 + fr, col0 = u.pn * 256 + wc * 32 + 4 * fq;
#pragma unroll
        for (int ai = 0; ai < 2; ++ai)
#pragma unroll
            for (int m = 0; m < 4; ++m) {
                float ss = 0.f;
#pragma unroll
                for (int bj = 0; bj < 2; ++bj)
#pragma unroll
                    for (int n = 0; n < 2; ++n) { const f32x4 v = acc[ai][bj][m][n]; ss += v[0] * v[0] + v[1] * v[1] + v[2] * v[2] + v[3] * v[3]; }
                ss += __shfl_xor(ss, 16); ss += __shfl_xor(ss, 32);
                if (fq == 0) __hip_atomic_store(part + (size_t)(row0 + ai * 128 + m * 16) * 16 + u.pn * 4 + wc, ss, __ATOMIC_RELAXED, __HIP_MEMORY_SCOPE_AGENT);
            }
        asm volatile("s_waitcnt vmcnt(0)" ::: "memory");
        const float* __restrict__ xr = x; float* __restrict__ outr = out;
        f32x4 xx0[2][2][2];
#pragma unroll
        for (int mm = 0; mm < 2; ++mm)
#pragma unroll
            for (int bj = 0; bj < 2; ++bj)
#pragma unroll
                for (int n = 0; n < 2; ++n) xx0[mm][bj][n] = *(const f32x4*)(xr + (size_t)(row0 + mm * 16) * DM + col0 + bj * 128 + n * 16);
        asm volatile("" ::: "memory");
        __syncthreads();
        if (threadIdx.x == 0) {
            __hip_atomic_fetch_add(cnt + u.pm, 1u, __ATOMIC_RELAXED, __HIP_MEMORY_SCOPE_AGENT);
            unsigned sp = 0; while (__hip_atomic_load(cnt + u.pm, __ATOMIC_RELAXED, __HIP_MEMORY_SCOPE_AGENT) < 4u && ++sp < (1u << 22)) __builtin_amdgcn_s_sleep(2);
        }
        f32x4 gv[2][2];
#pragma unroll
        for (int bj = 0; bj < 2; ++bj)
#pragma unroll
            for (int n = 0; n < 2; ++n) gv[bj][n] = *(const f32x4*)(g + col0 + bj * 128 + n * 16);
        __syncthreads();
        asm volatile("" ::: "memory");
        float rr[2][4];
#pragma unroll
        for (int ai = 0; ai < 2; ++ai)
#pragma unroll
            for (int m = 0; m < 4; ++m) {
                const float* pp = part + (size_t)(row0 + ai * 128 + m * 16) * 16 + 4 * fq;
                float t = 0.f;
#pragma unroll
                for (int j = 0; j < 4; ++j) t += __hip_atomic_load(pp + j, __ATOMIC_RELAXED, __HIP_MEMORY_SCOPE_AGENT);
                rr[ai][m] = t;
            }
#pragma unroll
        for (int q = 0; q < 4; ++q) {
            const int ai = q >> 1, m0 = (q & 1) * 2;
            f32x4 xx[2][2][2];
#pragma unroll
            for (int mm = 0; mm < 2; ++mm)
#pragma unroll
                for (int bj = 0; bj < 2; ++bj)
#pragma unroll
                    for (int n = 0; n < 2; ++n) xx[mm][bj][n] = q == 0 ? xx0[mm][bj][n] : *(const f32x4*)(xr + (size_t)(row0 + ai * 128 + (m0 + mm) * 16) * DM + col0 + bj * 128 + n * 16);
            asm volatile("" ::: "memory");
#pragma unroll
            for (int mm = 0; mm < 2; ++mm) {
                const int m = m0 + mm;
                float t = rr[ai][m];
                t += __shfl_xor(t, 16); t += __shfl_xor(t, 32);
                const float r = rsqrtf(t * (1.0f / 1024.0f) + 1e-6f);
                const size_t off = (size_t)(row0 + ai * 128 + m * 16) * DM + col0;
#pragma unroll
                for (int bj = 0; bj < 2; ++bj)
#pragma unroll
                    for (int n = 0; n < 2; ++n) __builtin_nontemporal_store(xx[mm][bj][n] + acc[ai][bj][m][n] * r * gv[bj][n], (f32x4*)(outr + off + bj * 128 + n * 16));
            }
        }
    }
};

__device__ __forceinline__ float xhalf_max(float x) { const auto r = __builtin_amdgcn_permlane32_swap(__float_as_uint(x), __float_as_uint(x), false, false); return fmaxf(__uint_as_float(r[0]), __uint_as_float(r[1])); }
__device__ __forceinline__ float xhalf_sum(float x) { const auto r = __builtin_amdgcn_permlane32_swap(__float_as_uint(x), __float_as_uint(x), false, false); return __uint_as_float(r[0]) + __uint_as_float(r[1]); }
__device__ __forceinline__ int crow(int r, int h) { return (r & 3) + 8 * (r >> 2) + 4 * h; }
#define MFMA32(a, b, c) __builtin_amdgcn_mfma_f32_32x32x16_bf16((a), (b), (c), 0, 0, 0)

constexpr int PD = 1;
template <int MODE, int NKT>
__device__ __forceinline__ void attn_core(const bf16_t* __restrict__ qrow, const bf16_t* __restrict__ kb, const bf16_t* __restrict__ vb, const int ld, const int res, const int dil,
                                          const int kidx0, const int nq, const int maxd, float& m, float& l, f32x16& o0, f32x16& o1, LAS unsigned char* vl, const int lane) {
    const int c = lane & 31, h = lane >> 5;
    const int q4 = (lane & 15) >> 2, p4 = lane & 3, g2 = (lane >> 4) & 1;
    LAS unsigned char* trb = vl + (4 * h + q4) * VROWB + 32 * g2 + 8 * p4;
    const int vr = lane >> 3, vc = lane & 7;
    LAS unsigned char* vw = vl + vr * VROWB + vc * 16;
    LAS unsigned char* kw = vl + ST_K + vr * KROWB + vc * 16;
    LAS unsigned char* krd = vl + ST_K + c * KROWB + 16 * h;
    u32x4 kreg[PD][4]; u32x4 vreg[PD][4];
    const long tstep = (long)32 * dil * ld, istep = (long)8 * dil * ld;
    const bf16_t* kp = kb + ((long)(res + dil * (kidx0 + vr)) * ld + vc * 8);
    const bf16_t* vp = vb + ((long)(res + dil * (kidx0 + vr)) * ld + vc * 8);
#define LOAD_TILE(kt, sl) do { \
        _Pragma("unroll") for (int i = 0; i < 4; ++i) { \
            kreg[sl][i] = *(const u32x4*)(kp + (kt) * tstep + i * istep); vreg[sl][i] = *(const u32x4*)(vp + (kt) * tstep + i * istep); } } while (0)
#pragma unroll
    for (int t = 0; t < PD; ++t) if (t < NKT) LOAD_TILE(t, t);
    bf16x8 qf[4];
#pragma unroll
    for (int kk = 0; kk < 4; ++kk) qf[kk] = *(const bf16x8*)(qrow + 16 * kk + 8 * h);
    asm volatile("" ::: "memory");
#pragma unroll 1
    for (int kt0 = 0; kt0 < NKT; kt0 += PD) {
#pragma unroll
      for (int sl = 0; sl < PD; ++sl) {
        const int kt = kt0 + sl;
        if (kt < NKT) {
#pragma unroll
        for (int i = 0; i < 4; ++i) { *(LAS u32x4*)(kw + i * 8 * KROWB) = kreg[sl][i]; *(LAS u32x4*)(vw + i * 8 * VROWB) = vreg[sl][i]; }
        f32x16 s;
#pragma unroll
        for (int r = 0; r < 16; ++r) s[r] = 0.f;
#pragma unroll
        for (int kk = 0; kk < 4; ++kk) { const bf16x8 kfr = *(LAS bf16x8*)(krd + 32 * kk); s = MFMA32(kfr, qf[kk], s); }
        asm volatile("" ::: "memory");
        if (kt + PD < NKT) { LOAD_TILE(kt + PD, sl); }
        asm volatile("" ::: "memory");
        if (MODE != 2 && (kt == 0 || kt == NKT - 1)) {
            const int nkb = kidx0 + 32 * kt;
#pragma unroll
            for (int r = 0; r < 16; ++r) { const int nk = nkb + crow(r, h), dist = nq - nk; s[r] = (nk >= 0 && dist >= 0 && dist <= maxd) ? s[r] : -INFINITY; }
        } else if (MODE != 2) {
            const int nkb = kidx0 + 32 * kt;
            if (nkb < 0) {
#pragma unroll
                for (int r = 0; r < 16; ++r) { const int nk = nkb + crow(r, h); s[r] = nk >= 0 ? s[r] : -INFINITY; }
            }
        }
        float mx = s[0];
#pragma unroll
        for (int r = 1; r < 16; ++r) mx = fmaxf(mx, s[r]);
        mx = xhalf_max(mx);
        if (__builtin_amdgcn_ballot_w64(mx > m + 8.0f) != 0ull) {
            const float mnew = fmaxf(m, mx);
            const float alpha = mnew == -INFINITY ? 1.0f : __builtin_amdgcn_exp2f(m - mnew);
            l *= alpha; o0 *= alpha; o1 *= alpha; m = mnew;
        }
        const float mref = m == -INFINITY ? 0.f : m;
        float rs = 0.f;
#pragma unroll
        for (int r = 0; r < 16; ++r) { s[r] = __builtin_amdgcn_exp2f(s[r] - mref); rs += s[r]; }
        l += rs;
        bf16x8 pf[2];
#pragma unroll
        for (int s2 = 0; s2 < 2; ++s2) { u32x4 w; w.x = pack2(s[8 * s2], s[8 * s2 + 1]); w.y = pack2(s[8 * s2 + 2], s[8 * s2 + 3]); w.z = pack2(s[8 * s2 + 4], s[8 * s2 + 5]); w.w = pack2(s[8 * s2 + 6], s[8 * s2 + 7]);
            pf[s2] = __builtin_bit_cast(bf16x8, w); }
#pragma unroll
        for (int s2 = 0; s2 < 2; ++s2) {
            const s16x4 a0 = __builtin_amdgcn_ds_read_tr16_b64_v4i16((LAS s16x4*)(trb + (16 * s2) * VROWB));
            const s16x4 a1 = __builtin_amdgcn_ds_read_tr16_b64_v4i16((LAS s16x4*)(trb + (16 * s2 + 8) * VROWB));
            const s16x4 b0 = __builtin_amdgcn_ds_read_tr16_b64_v4i16((LAS s16x4*)(trb + (16 * s2) * VROWB + 64));
            const s16x4 b1 = __builtin_amdgcn_ds_read_tr16_b64_v4i16((LAS s16x4*)(trb + (16 * s2 + 8) * VROWB + 64));
            const bf16x8 va = __builtin_shufflevector(a0, a1, 0, 1, 2, 3, 4, 5, 6, 7), vbv = __builtin_shufflevector(b0, b1, 0, 1, 2, 3, 4, 5, 6, 7);
            o0 = MFMA32(va, pf[s2], o0);
            o1 = MFMA32(vbv, pf[s2], o1);
        }
        }
      }
    }
#undef LOAD_TILE
}

template <int NKT>
__device__ __forceinline__ void attn_core_img(const bf16_t* __restrict__ qrow, LAS unsigned char* kimg, LAS unsigned char* vimg, float& m, float& l, f32x16& o0, f32x16& o1, const int lane) {
    const int c = lane & 31, h = lane >> 5;
    const int q4 = (lane & 15) >> 2, p4 = lane & 3, g2 = (lane >> 4) & 1;
    LAS unsigned char* trb = vimg + (4 * h + q4) * VROWB + 32 * g2 + 8 * p4;
    LAS unsigned char* krd = kimg + c * KROWB + 16 * h;
    bf16x8 qf[4];
#pragma unroll
    for (int kk = 0; kk < 4; ++kk) qf[kk] = *(const bf16x8*)(qrow + 16 * kk + 8 * h);
#pragma unroll 1
    for (int kt = 0; kt < NKT; ++kt) {
        f32x16 s;
#pragma unroll
        for (int r = 0; r < 16; ++r) s[r] = 0.f;
#pragma unroll
        for (int kk = 0; kk < 4; ++kk) { const bf16x8 kfr = *(LAS bf16x8*)(krd + kt * 32 * KROWB + 32 * kk); s = MFMA32(kfr, qf[kk], s); }
        float mx = s[0];
#pragma unroll
        for (int r = 1; r < 16; ++r) mx = fmaxf(mx, s[r]);
        mx = xhalf_max(mx);
        if (__builtin_amdgcn_ballot_w64(mx > m + 8.0f) != 0ull) {
            const float mnew = fmaxf(m, mx);
            const float alpha = mnew == -INFINITY ? 1.0f : __builtin_amdgcn_exp2f(m - mnew);
            l *= alpha; o0 *= alpha; o1 *= alpha; m = mnew;
        }
        const float mref = m == -INFINITY ? 0.f : m;
        float rs = 0.f;
#pragma unroll
        for (int r = 0; r < 16; ++r) { s[r] = __builtin_amdgcn_exp2f(s[r] - mref); rs += s[r]; }
        l += rs;
        bf16x8 pf[2];
#pragma unroll
        for (int s2 = 0; s2 < 2; ++s2) { u32x4 w; w.x = pack2(s[8 * s2], s[8 * s2 + 1]); w.y = pack2(s[8 * s2 + 2], s[8 * s2 + 3]); w.z = pack2(s[8 * s2 + 4], s[8 * s2 + 5]); w.w = pack2(s[8 * s2 + 6], s[8 * s2 + 7]);
            pf[s2] = __builtin_bit_cast(bf16x8, w); }
        LAS unsigned char* tb = trb + kt * 32 * VROWB;
#pragma unroll
        for (int s2 = 0; s2 < 2; ++s2) {
            const s16x4 a0 = __builtin_amdgcn_ds_read_tr16_b64_v4i16((LAS s16x4*)(tb + (16 * s2) * VROWB));
            const s16x4 a1 = __builtin_amdgcn_ds_read_tr16_b64_v4i16((LAS s16x4*)(tb + (16 * s2 + 8) * VROWB));
            const s16x4 b0 = __builtin_amdgcn_ds_read_tr16_b64_v4i16((LAS s16x4*)(tb + (16 * s2) * VROWB + 64));
            const s16x4 b1 = __builtin_amdgcn_ds_read_tr16_b64_v4i16((LAS s16x4*)(tb + (16 * s2 + 8) * VROWB + 64));
            const bf16x8 va = __builtin_shufflevector(a0, a1, 0, 1, 2, 3, 4, 5, 6, 7), vbv = __builtin_shufflevector(b0, b1, 0, 1, 2, 3, 4, 5, 6, 7);
            o0 = MFMA32(va, pf[s2], o0);
            o1 = MFMA32(vbv, pf[s2], o1);
        }
    }
}

__device__ __forceinline__ float silu(float g) { return g * __builtin_amdgcn_rcpf(1.0f + __expf(-g)); }
__device__ __forceinline__ void attn_finalize(const f32x16& o0, const f32x16& o1, float l, const bf16_t* __restrict__ gtile, bf16_t* __restrict__ ytile, LAS unsigned char* vl, int lane) {
    const int c = lane & 31, h = lane >> 5, vr = lane >> 3, vc = lane & 7;
    u32x4 gv[4];
#pragma unroll
    for (int i = 0; i < 4; ++i) gv[i] = *(const u32x4*)(gtile + (size_t)(vr + 8 * i) * 64 + vc * 8);
    const float inv = __builtin_amdgcn_rcpf(l);
#pragma unroll
    for (int cc = 0; cc < 2; ++cc)
#pragma unroll
        for (int g = 0; g < 4; ++g) {
            const f32x16& o = cc ? o1 : o0;
            u32x2 w; w.x = pack2(o[4 * g] * inv, o[4 * g + 1] * inv); w.y = pack2(o[4 * g + 2] * inv, o[4 * g + 3] * inv);
            *(LAS u32x2*)(vl + c * 136 + (32 * cc + 8 * g + 4 * h) * 2) = w;
        }
#pragma unroll
    for (int i = 0; i < 4; ++i) {
        const int r = vr + 8 * i;
        const u32x2 lo = *(LAS u32x2*)(vl + r * 136 + vc * 16), hi = *(LAS u32x2*)(vl + r * 136 + vc * 16 + 8);
        const unsigned ov[4] = {lo.x, lo.y, hi.x, hi.y};
        u32x4 w;
#pragma unroll
        for (int j = 0; j < 4; ++j) { const float y0 = bflo(ov[j]) * bflo(gv[i][j]), y1 = bfhi(ov[j]) * bfhi(gv[i][j]); w[j] = pack2(y0, y1); }
        *(u32x4*)(ytile + (size_t)r * DM + vc * 8) = w;
    }
}

__device__ __forceinline__ void phase_attn(const Params& p, LAS unsigned char* lds, int rep, int item_lo, int item_hi, unsigned xcc) {
    const bf16_t* proj = (const bf16_t*)(p.ws + OFF_PROJ); const bf16_t* mkv = (const bf16_t*)(p.ws + OFF_MKV); bf16_t* Y = (bf16_t*)(p.ws + OFF_Y);
    unsigned* ctr = (unsigned*)(p.ws + OFF_CTR) + rep * 8;
    const int tid = threadIdx.x, lane = tid & 63, wid = tid >> 6, c = lane & 31, h = lane >> 5;
    LAS unsigned char* vl = lds + ST_V + wid * ST_VW;
    LAS int* item_s = (LAS int*)(lds + ST_ITEM);
    unsigned* memflag = (unsigned*)(p.ws + OFF_CNT) + 192;
    if (rep == 0 && blockIdx.x < 8) {
        pg8::Gemm g; g.A = (const bf16_t*)(p.ws + OFF_U); g.Bt = (const bf16_t*)(p.ws + OFF_WINT); g.M = NTOK; g.N = DIN; g.K = DM;
        MemUnit S; S.L = (int)blockIdx.x;
        EpiIn E; E.proj = (bf16_t*)(p.ws + OFF_PROJ); E.mkv = (bf16_t*)(p.ws + OFF_MKV); E.rope = (const float*)(p.ws + OFF_ROPE);
        pg8::gemm_phase<EpiIn, MemUnit, false>(lds, g, S, E, nullptr);
        asm volatile("s_waitcnt vmcnt(0)" ::: "memory");
        __syncthreads();
        if (tid == 0) { __threadfence(); __hip_atomic_fetch_add(memflag, 1u, __ATOMIC_RELAXED, __HIP_MEMORY_SCOPE_AGENT); }
    }
    unsigned* qctr = (unsigned*)(p.ws + OFF_QCTR) + rep * 8 * 64;
    int dq = 0;
    for (int itn = 0;; ++itn) {
        if (tid == 0) {
            int code = -1;
            while (dq < 8) {
                const int q_ = (int)((xcc + (unsigned)dq) & 7u);
                if (__hip_atomic_load(qctr + q_ * 64, __ATOMIC_RELAXED, __HIP_MEMORY_SCOPE_AGENT) < 128u) {
                    const int j_ = (int)atomicAdd(qctr + q_ * 64, 1u);
                    if (j_ < 128) { code = q_ * 128 + j_; break; }
                }
                ++dq;
            }
            item_s[itn & 1] = code;
        }
        __syncthreads();
        const int code = __builtin_amdgcn_readfirstlane(item_s[itn & 1]);
        if (code < 0) break;
        const int qi = code >> 7, j = code & 127;
        int item;
        if (j < 48) { const int pair = qi + 8 * (j >> 4), b_ = pair / 6, hd = pair - b_ * 6; item = (b_ * 16 + (j & 15)) * 6 + hd; }
        else if (j < 96) { const int jj = j - 48, b_ = qi >> 1, kvh_ = qi & 1, stl = jj / 3, g_ = jj - stl * 3; item = 640 + (b_ * 16 + stl) * 6 + kvh_ * 3 + g_; }
        else { const int jj = j - 96, pair = qi + 8 * (jj >> 4), b_ = pair >> 2, hd = pair & 3; item = 384 + (b_ * 16 + (jj & 15)) * 4 + hd; }
        if (item < item_lo || item >= item_hi) continue;
        if (wid >= 4) __builtin_amdgcn_s_sleep(12);
        if (item < 384) {
            const int st = item / 6, head = item - st * 6, b = st >> 4, t0 = (st & 15) * 512;
            const size_t hb = (size_t)b * SEQ * 64;
            const bf16_t* qh_ = proj + (size_t)(16 + head) * NTOK * 64 + hb; const bf16_t* kh_ = proj + (size_t)(22 + head) * NTOK * 64 + hb;
            const bf16_t* vh_ = proj + (size_t)(28 + head) * NTOK * 64 + hb; const bf16_t* gh_ = proj + (size_t)(34 + head) * NTOK * 64 + hb;
#pragma unroll 1
            for (int pass = 0; pass < 3; ++pass) {
                const int dil = pass == 0 ? 16 : (pass == 1 ? 4 : 1);
#pragma unroll 1
                for (int su = wid; su < 16; su += 8) {
                    int res, n0;
                    if (pass == 0) { res = su; n0 = t0 >> 4; } else if (pass == 1) { res = su & 3; n0 = (t0 >> 2) + 32 * (su >> 2); } else { res = 0; n0 = t0 + 32 * su; }
                    const int nq = n0 + c, posq = res + dil * nq, tokl = posq - t0, rowp = tokl ^ ((tokl >> 4) & 15);
                    LAS unsigned char* so = lds + rowp * ST_ROWB + 8 * h;
                    LAS float* sml = (LAS float*)(lds + ST_ML + rowp * 8);
                    float m, l; f32x16 o0, o1;
                    if (pass == 0) { m = -INFINITY; l = 0.f;
#pragma unroll
                        for (int r = 0; r < 16; ++r) { o0[r] = 0.f; o1[r] = 0.f; }
                    } else {
                        m = sml[0]; l = h == 0 ? sml[1] : 0.f;
#pragma unroll
                        for (int g = 0; g < 4; ++g) {
                            const u32x2 a = *(LAS u32x2*)(so + 16 * g), bb = *(LAS u32x2*)(so + 64 + 16 * g);
                            o0[4 * g] = bflo(a.x); o0[4 * g + 1] = bfhi(a.x); o0[4 * g + 2] = bflo(a.y); o0[4 * g + 3] = bfhi(a.y);
                            o1[4 * g] = bflo(bb.x); o1[4 * g + 1] = bfhi(bb.x); o1[4 * g + 2] = bflo(bb.y); o1[4 * g + 3] = bfhi(bb.y);
                        }
                    }
                    attn_core<1, 5>(qh_ + (size_t)posq * 64, kh_, vh_, 64, res, dil, n0 - 128, nq, 128, m, l, o0, o1, vl, lane);
                    l = xhalf_sum(l);
                    if (pass < 2) {
                        if (h == 0) { sml[0] = m; sml[1] = l; }
#pragma unroll
                        for (int g = 0; g < 4; ++g) {
                            u32x2 a, bb; a.x = pack2(o0[4 * g], o0[4 * g + 1]); a.y = pack2(o0[4 * g + 2], o0[4 * g + 3]); bb.x = pack2(o1[4 * g], o1[4 * g + 1]); bb.y = pack2(o1[4 * g + 2], o1[4 * g + 3]);
                            *(LAS u32x2*)(so + 16 * g) = a; *(LAS u32x2*)(so + 64 + 16 * g) = bb;
                        }
                    } else {
                        attn_finalize(o0, o1, l, gh_ + (size_t)n0 * 64, Y + ((size_t)b * SEQ + n0) * DM + 384 + head * 64, vl, lane);
                    }
                }
                if (pass < 2) __syncthreads();
            }
        } else if (item < 640) {
            const int idx = item - 384, st = idx >> 2, head = idx & 3, b = st >> 4, t0 = (st & 15) * 512;
            if (tid == 0) { unsigned sp = 0; while (__hip_atomic_load(memflag, __ATOMIC_RELAXED, __HIP_MEMORY_SCOPE_AGENT) < 8u && ++sp < (1u << 22)) __builtin_amdgcn_s_sleep(2); }
            __syncthreads();
            __builtin_amdgcn_fence(__ATOMIC_ACQUIRE, "agent");
            const bf16_t* kb = mkv + (size_t)b * 256 * 512 + head * 64;
            LAS unsigned char* kimg = lds + ST_V; LAS unsigned char* vimg = lds + ST_V + 256 * KROWB;
            {
                u32x4 kk_[4], vv_[4];
#pragma unroll
                for (int i = 0; i < 4; ++i) { const int ch = tid + 512 * i, row = ch >> 3, vc_ = ch & 7;
                    kk_[i] = *(const u32x4*)(kb + (size_t)row * 512 + vc_ * 8); vv_[i] = *(const u32x4*)(kb + 256 + (size_t)row * 512 + vc_ * 8); }
#pragma unroll
                for (int i = 0; i < 4; ++i) { const int ch = tid + 512 * i, row = ch >> 3, vc_ = ch & 7;
                    *(LAS u32x4*)(kimg + row * KROWB + vc_ * 16) = kk_[i]; *(LAS u32x4*)(vimg + row * VROWB + vc_ * 16) = vv_[i]; }
            }
            __syncthreads();
            LAS unsigned char* vfin = lds + wid * 4608;
#pragma unroll 1
            for (int su = wid; su < 16; su += 8) {
                const size_t row0 = (size_t)b * SEQ + t0 + 32 * su;
                float m = -INFINITY, l = 0.f; f32x16 o0, o1;
#pragma unroll
                for (int r = 0; r < 16; ++r) { o0[r] = 0.f; o1[r] = 0.f; }
                attn_core_img<8>(proj + ((size_t)(40 + head) * NTOK + row0 + c) * 64, kimg, vimg, m, l, o0, o1, lane);
                l = xhalf_sum(l);
                attn_finalize(o0, o1, l, proj + ((size_t)(44 + head) * NTOK + row0) * 64, Y + row0 * DM + 768 + head * 64, vfin, lane);
            }
        } else {
            const int idx = item - 640, st = idx / 6, qh = idx - st * 6, kvh = qh / 3, b = st >> 4, t0 = (st & 15) * 512;
            const size_t hb = (size_t)b * SEQ * 64;
            const bf16_t* qh_ = proj + (size_t)qh * NTOK * 64 + hb; const bf16_t* kh_ = proj + (size_t)(6 + kvh) * NTOK * 64 + hb;
            const bf16_t* vh_ = proj + (size_t)(8 + kvh) * NTOK * 64 + hb; const bf16_t* gh_ = proj + (size_t)(10 + qh) * NTOK * 64 + hb;
            const float sink = p.sink[qh] * 1.4426950408889634f;
#pragma unroll 1
            for (int su = wid; su < 16; su += 8) {
                const int n0 = t0 + 32 * su, nq = n0 + c;
                float m = sink, l = h == 0 ? 1.0f : 0.f; f32x16 o0, o1;
#pragma unroll
                for (int r = 0; r < 16; ++r) { o0[r] = 0.f; o1[r] = 0.f; }
                attn_core<0, 5>(qh_ + (size_t)nq * 64, kh_, vh_, 64, 0, 1, n0 - 128, nq, 127, m, l, o0, o1, vl, lane);
                l = xhalf_sum(l);
                attn_finalize(o0, o1, l, gh_ + (size_t)n0 * 64, Y + ((size_t)b * SEQ + n0) * DM + qh * 64, vl, lane);
            }
        }
    }
}

__device__ __forceinline__ void phase_post(const Params& p) {
    const int tid = threadIdx.x, lane = tid & 63, wid = tid >> 6, gw = blockIdx.x * 8 + wid, nw = gridDim.x * 8;
    const float* Z = (const float*)(p.ws + OFF_Z);
    for (int row = gw; row < NTOK; row += 2 * nw) {
        const int row2 = row + nw < NTOK ? row + nw : row;
        f32x4 v[4], w2[4], xa[4], xb2[4];
#pragma unroll
        for (int i = 0; i < 4; ++i) { v[i] = *(const f32x4*)(Z + (size_t)row * DM + i * 256 + lane * 4); w2[i] = *(const f32x4*)(Z + (size_t)row2 * DM + i * 256 + lane * 4);
                                      xa[i] = *(const f32x4*)(p.x + (size_t)row * DM + i * 256 + lane * 4); xb2[i] = *(const f32x4*)(p.x + (size_t)row2 * DM + i * 256 + lane * 4); }
        float ss = 0.f, ss2 = 0.f;
#pragma unroll
        for (int i = 0; i < 4; ++i) { ss += v[i][0] * v[i][0] + v[i][1] * v[i][1] + v[i][2] * v[i][2] + v[i][3] * v[i][3];
                                      ss2 += w2[i][0] * w2[i][0] + w2[i][1] * w2[i][1] + w2[i][2] * w2[i][2] + w2[i][3] * w2[i][3]; }
        ss = wave_sum(ss); ss2 = wave_sum(ss2);
        const float r = rsqrtf(ss * (1.0f / 1024.0f) + 1e-6f), r2 = rsqrtf(ss2 * (1.0f / 1024.0f) + 1e-6f);
#pragma unroll
        for (int i = 0; i < 4; ++i) {
            const f32x4 gg = *(const f32x4*)(p.post_g + i * 256 + lane * 4);
            *(f32x4*)(p.out + (size_t)row * DM + i * 256 + lane * 4) = xa[i] + v[i] * r * gg;
            *(f32x4*)(p.out + (size_t)row2 * DM + i * 256 + lane * 4) = xb2[i] + w2[i] * r2 * gg;
        }
    }
}


#define XB_TMO      128
#define XB_XCNT(j)  (256  + 64 * (j))
#define XB_XSUB(j)  (1280 + 64 * (j))
#define XB_XGEN(j)  (2304 + 64 * (j))
#define XB_TOP      3328
#define XB_TOPGEN   3392
#define XCD_BAR_WORDS 3456
#define XB_SPIN_CAP (1u << 18)

__device__ __forceinline__ unsigned xb_ld(unsigned* p)              { return __hip_atomic_load(p, __ATOMIC_RELAXED, __HIP_MEMORY_SCOPE_AGENT); }
__device__ __forceinline__ unsigned xb_add(unsigned* p, unsigned v) { return __hip_atomic_fetch_add(p, v, __ATOMIC_RELAXED, __HIP_MEMORY_SCOPE_AGENT); }
__device__ __forceinline__ unsigned xb_xcc_id() { return (unsigned)__builtin_amdgcn_s_getreg((3 << 11) | 20) & 0xFu; }
#define XB_SPIN(cond, bar) do { unsigned _sp = 0; while (cond) { __builtin_amdgcn_s_sleep(1); \
    if ((++_sp & 255u) == 0u) { if (xb_ld(&(bar)[XB_TMO])) break; if (_sp > XB_SPIN_CAP) { atomicAdd(&(bar)[XB_TMO], 1u); break; } } } } while (0)

struct XcdBarrier {
    unsigned* bar; unsigned x;
    volatile LAS unsigned* st;
};

__device__ __forceinline__ XcdBarrier xcd_barrier_post(unsigned* bar, volatile LAS unsigned* st) {
    XcdBarrier b; b.bar = bar; b.x = xb_xcc_id(); b.st = st;
    if (threadIdx.x == 0) (void)xb_add(&bar[XB_XCNT(b.x)], 1u);
    return b;
}
__device__ __forceinline__ void xcd_barrier_complete(unsigned* bar, unsigned x, unsigned& nloc, unsigned& nx) {
    const unsigned G = gridDim.x * gridDim.y * gridDim.z;
    unsigned sum, cnt, mine, sp = 0u;
    for (;;) {
        sum = 0u; cnt = 0u; mine = 0u;
#pragma unroll
        for (unsigned j = 0; j < 16; ++j) { const unsigned c = xb_ld(&bar[XB_XCNT(j)]); sum += c; cnt += (c > 0u) ? 1u : 0u; mine = (j == x) ? c : mine; }
        if (sum == G) break;
        __builtin_amdgcn_s_sleep(1);
        if ((++sp & 255u) == 0u) { if (xb_ld(&bar[XB_TMO])) break; if (sp > XB_SPIN_CAP) { atomicAdd(&bar[XB_TMO], 1u); break; } }
    }
    nloc = mine > 0u ? mine : 1u; nx = cnt > 0u ? cnt : 1u;
}

__device__ __forceinline__ void xcd_barrier(const XcdBarrier& b) {
    asm volatile("s_waitcnt vmcnt(0)" ::: "memory");
    __syncthreads();
    if (threadIdx.x == 0) {
        unsigned* bar = b.bar;
        __builtin_amdgcn_s_waitcnt(0);
        unsigned nloc = b.st[0], nx = b.st[1];
        if (nloc == 0u) { xcd_barrier_complete(bar, b.x, nloc, nx); b.st[0] = nloc; b.st[1] = nx; }
        const unsigned old = xb_add(&bar[XB_XSUB(b.x)], 1u);
        const unsigned gen = old / nloc;
        if (old + 1u == (gen + 1u) * nloc) {
            __builtin_amdgcn_fence(__ATOMIC_RELEASE, "agent");
            asm volatile("s_waitcnt vmcnt(0)" ::: "memory");
            const unsigned og = xb_add(&bar[XB_TOP], 1u);
            const unsigned tg = og / nx;
            if (og + 1u == (tg + 1u) * nx) xb_add(&bar[XB_TOPGEN], 1u);
            else XB_SPIN(xb_ld(&bar[XB_TOPGEN]) == tg, bar);
            __builtin_amdgcn_fence(__ATOMIC_ACQUIRE, "agent");
            xb_add(&bar[XB_XGEN(b.x)], 1u);
            asm volatile("s_waitcnt vmcnt(0)" ::: "memory");
        } else {
            XB_SPIN(xb_ld(&bar[XB_XGEN(b.x)]) == gen, bar);
            __builtin_amdgcn_fence(__ATOMIC_ACQUIRE, "agent");
            asm volatile("s_waitcnt vmcnt(0)" ::: "memory");
        }
    }
    __syncthreads();
}

__global__ __launch_bounds__(512, 2) void fwd_kernel(Params p) {
    extern __shared__ __attribute__((aligned(16))) unsigned char smem[];
    cg::grid_group grid = cg::this_grid();
    LAS unsigned char* lds = (LAS unsigned char*)smem;
    if (threadIdx.x < 4) ((LAS unsigned*)(lds + ST_XB))[threadIdx.x] = 0u;
    __syncthreads();
    const XcdBarrier xb = xcd_barrier_post((unsigned*)(p.ws + OFF_BAR), (volatile LAS unsigned*)(lds + ST_XB));
    if (p.out == nullptr) grid.sync();
#define GSYNC() xcd_barrier(xb)
#define GIN_BLOCK { \
        pg8::Gemm g; g.A = (const bf16_t*)(p.ws + OFF_U); g.Bt = (const bf16_t*)(p.ws + OFF_WINT); g.M = NTOK; g.N = DIN; g.K = DM; \
        pg8::StaticOrder S; S.init(NTOK, DIN, (int)gridDim.x, (int)blockIdx.x); \
        EpiIn E; E.proj = (bf16_t*)(p.ws + OFF_PROJ); E.mkv = (bf16_t*)(p.ws + OFF_MKV); E.rope = (const float*)(p.ws + OFF_ROPE); \
        pg8::gemm_phase<EpiIn, pg8::StaticOrder, false>(lds, g, S, E, nullptr); \
        GSYNC(); }
#define GOUT_BLOCK { \
        pg8::Gemm g; g.A = (const bf16_t*)(p.ws + OFF_Y); g.Bt = (const bf16_t*)(p.ws + OFF_WOUTT); g.M = NTOK; g.N = DM; g.K = DM; \
        OneUnit S; S.so.init(NTOK, DM, (int)gridDim.x, (int)blockIdx.x); \
        EpiOutFused E; E.x = p.x; E.g = p.post_g; E.out = p.out; E.part = (float*)(p.ws + OFF_PART); E.cnt = (unsigned*)(p.ws + OFF_CNT); \
        S.round = 0; pg8::gemm_phase<EpiOutFused, OneUnit, false>(lds, g, S, E, nullptr); \
        S.round = 1; pg8::gemm_phase<EpiOutFused, OneUnit, false>(lds, g, S, E, nullptr); }
    phase_prep(p); GSYNC();
#ifdef REP_SYNC
    GSYNC(); GSYNC(); GSYNC(); GSYNC(); GSYNC(); GSYNC(); GSYNC(); GSYNC();
#endif
#ifdef REP_PREP
    phase_prep(p); GSYNC();
#endif
    GIN_BLOCK
#if REP_GIN > 1
    GIN_BLOCK
#endif
    phase_attn(p, lds, 0, 0, 1024, xb.x); GSYNC();
#if REP_ATTN > 1
    phase_attn(p, lds, 1, REP_LO, REP_HI, xb.x); GSYNC();
#endif
    GOUT_BLOCK
#ifdef REP_GOUT
    if (gridDim.x == 256u) GOUT_BLOCK
    else {
        pg8::Gemm g; g.A = (const bf16_t*)(p.ws + OFF_Y); g.Bt = (const bf16_t*)(p.ws + OFF_WOUTT); g.M = NTOK; g.N = DM; g.K = DM;
        pg8::StaticOrder S; S.init(NTOK, DM, (int)gridDim.x, (int)blockIdx.x);
        pg8::EpiF32 E; E.C = (float*)(p.ws + OFF_Z); E.ldc = DM; E.bias = nullptr;
        pg8::gemm_phase<pg8::EpiF32, pg8::StaticOrder, false>(lds, g, S, E, nullptr);
        GSYNC();
        phase_post(p);
    }
#endif
}

extern "C" void kernel_launch(void* const* d_in, const int* in_sizes, int n_in, void* d_out, int out_size, void* d_ws, size_t ws_size, hipStream_t stream) {
    static int grid_blocks = 0;
    if (!grid_blocks) {
        int dev = 0, cus = 0, per_cu = 0;
        hipGetDevice(&dev);
        hipDeviceGetAttribute(&cus, hipDeviceAttributeMultiprocessorCount, dev);
        hipFuncSetAttribute((const void*)fwd_kernel, hipFuncAttributeMaxDynamicSharedMemorySize, LDS_BYTES);
        hipOccupancyMaxActiveBlocksPerMultiprocessor(&per_cu, (const void*)fwd_kernel, 512, LDS_BYTES);
        if (per_cu < 1) { fprintf(stderr, "occupancy query returned %d\n", per_cu); per_cu = 1; }
        grid_blocks = cus * per_cu;
    }
    Params p{};
    p.x = (const float*)d_in[0]; p.mem = (const float*)d_in[1]; p.pre_g = (const float*)d_in[2]; p.w_in = (const float*)d_in[3]; p.sink = (const float*)d_in[4];
    p.mem_g = (const float*)d_in[5]; p.w_memkv = (const float*)d_in[6]; p.w_out = (const float*)d_in[7]; p.post_g = (const float*)d_in[8];
    p.out = (float*)d_out; p.ws = (unsigned char*)d_ws;
    void* args[] = {&p};
    hipMemsetAsync((unsigned char*)d_ws + OFF_BAR, 0, 16384 + 8192, stream);
    hipError_t e = hipLaunchCooperativeKernel((const void*)fwd_kernel, dim3(grid_blocks), dim3(512), args, LDS_BYTES, stream);
    if (e != hipSuccess) fprintf(stderr, "cooperative launch failed: %s (grid %d)\n", hipGetErrorString(e), grid_blocks);
}
```
